# Optimizing an MI355X kernel written in HIP

```python
import jax, jax.numpy as jnp
from jax import lax
import numpy as np

D_MODEL = 1024
BATCH = 8
SEQ = 2048
DEPTH = 2
DEC_BATCH = 128
DEC_SEQ = 8
PAST_LEN = 16384
PAGE_SIZE = 128

N_A_LAYERS = DEPTH // 2
N_B_LAYERS = DEPTH - N_A_LAYERS
D_RNN = D_MODEL
N_RNN_BLOCKS = 8
RNN_BLOCK = D_RNN // N_RNN_BLOCKS
CONV_WIDTH = 4
RG_C = 8.0
HEAD_DIM = 64
N_HEADS = D_MODEL // HEAD_DIM
N_KV_HEADS = 4
GROUP = N_HEADS // N_KV_HEADS
WINDOW = 128
ROT_DIM = HEAD_DIM // 4
ROPE_THETA = 500000.0
D_FF = ((8 * D_MODEL + 3 * 256 - 1) // (3 * 256)) * 256
EPS = 1e-6
NEG_INF = -1e30

kernel_name = 'yoco_rglru_swa_sink_adaln_step'


def rms_norm(x, g):
    xf = x.astype(jnp.float32)
    y = xf * lax.rsqrt(jnp.mean(xf * xf, axis=-1, keepdims=True) + EPS)
    return (y * g.astype(jnp.float32)).astype(x.dtype)


def modulate(h, shift, scale):
    return h * (1 + scale[:, None, :]) + shift[:, None, :]


def ada_mod(c, w, b, n):
    return jnp.split(jax.nn.silu(c) @ w + b, n, axis=-1)


def swiglu(h, w_in, w_out):
    gate, up = jnp.split(h @ w_in, 2, axis=-1)
    return (jax.nn.silu(gate) * up) @ w_out


def apply_partial_rope(x, pos):
    inv = ROPE_THETA ** (-jnp.arange(0, ROT_DIM, 2, dtype=jnp.float32) / ROT_DIM)
    ang = pos.astype(jnp.float32)[:, None] * inv[None, :]
    cos = jnp.cos(ang)[None, :, None, :]
    sin = jnp.sin(ang)[None, :, None, :]
    xf = x.astype(jnp.float32)
    x1 = xf[..., :ROT_DIM // 2]
    x2 = xf[..., ROT_DIM // 2:ROT_DIM]
    out = jnp.concatenate([x1 * cos - x2 * sin, x2 * cos + x1 * sin, xf[..., ROT_DIM:]], axis=-1)
    return out.astype(x.dtype)


def causal_dwconv(x, buf, w, b):
    T = x.shape[1]
    xpad = jnp.concatenate([buf.astype(x.dtype), x], axis=1)
    y = b
    for k in range(CONV_WIDTH):
        y = y + w[k] * xpad[:, k:k + T]
    return y, xpad[:, xpad.shape[1] - (CONV_WIDTH - 1):]


def rg_lru(x, gate_w, gate_b, lam, h0):
    B, T, _ = x.shape
    xb = x.reshape(B, T, N_RNN_BLOCKS, RNN_BLOCK)
    g = jnp.einsum('btnc,ncd->btnd', xb, gate_w) + gate_b
    g = jax.nn.sigmoid(g.astype(jnp.float32))
    r = g[..., :RNN_BLOCK].reshape(B, T, D_RNN)
    i = g[..., RNN_BLOCK:].reshape(B, T, D_RNN)
    log_a = RG_C * r * jax.nn.log_sigmoid(lam.astype(jnp.float32))
    a = jnp.exp(log_a)
    u = jnp.sqrt(-jnp.expm1(2.0 * log_a)) * (i * x.astype(jnp.float32))

    def step(h, au):
        h = au[0] * h + au[1]
        return h, h

    h_last, hs = lax.scan(step, h0.astype(jnp.float32),
                          (jnp.swapaxes(a, 0, 1), jnp.swapaxes(u, 0, 1)))
    return jnp.swapaxes(hs, 0, 1).astype(x.dtype), h_last


def recurrent_block(h, w_in, conv_w, conv_b, gate_w, gate_b, lam, w_out, conv_buf, h0):
    xr, yg = jnp.split(h @ w_in, 2, axis=-1)
    xr, new_buf = causal_dwconv(xr, conv_buf, conv_w, conv_b)
    o, h_last = rg_lru(xr, gate_w, gate_b, lam, h0)
    return (o * jax.nn.gelu(yg, approximate=True)) @ w_out, new_buf, h_last


def sliding_sink_attention(q, k_all, v_all, sinks, p0):
    B, T = q.shape[:2]
    qb = WINDOW if T % WINDOW == 0 else T
    nb = T // qb
    span = qb + WINDOW
    idx = (jnp.arange(nb) * qb)[:, None] + jnp.arange(span)[None, :]
    kb = k_all[:, idx]
    vb = v_all[:, idx]
    qg = q.reshape(B, nb, qb, N_KV_HEADS, GROUP, HEAD_DIM)
    s = jnp.einsum('bnqkgd,bnskd->bnkgqs', qg, kb).astype(jnp.float32) * (HEAD_DIM ** -0.5)
    rel = WINDOW + jnp.arange(qb)[:, None] - jnp.arange(span)[None, :]
    mask = ((rel >= 0) & (rel <= WINDOW))[None] & ((p0 - WINDOW + idx) >= 0)[:, None, :]
    s = jnp.where(mask[None, :, None, None], s, NEG_INF)
    sink = sinks.astype(jnp.float32).reshape(1, 1, N_KV_HEADS, GROUP, 1, 1)
    m = jnp.maximum(jnp.max(s, axis=-1, keepdims=True), sink)
    e = jnp.exp(s - m)
    p = e / (jnp.sum(e, axis=-1, keepdims=True) + jnp.exp(sink - m))
    o = jnp.einsum('bnkgqs,bnskd->bnqkgd', p.astype(vb.dtype), vb)
    return o.reshape(B, T, N_HEADS * HEAD_DIM)


def trunk(x, c, p0, conv_bufs, h0s, k_prev, v_prev, params):
    (ada_w, ada_b, norm_g, rnn_w_in, rnn_conv_w, rnn_conv_b, rnn_gate_w, rnn_gate_b,
     rnn_lambda, rnn_w_out, kv_ada_w, kv_ada_b, kv_norm_g, w_kv, attn_w_q, attn_sinks,
     attn_w_o, ffn_w_in, ffn_w_out, final_g) = params
    B, T, _ = x.shape
    pos = p0 + jnp.arange(T, dtype=jnp.int32)
    new_conv, new_h = [], []
    k_all = v_all = None
    for l in range(DEPTH):
        sh1, sc1, g1, sh2, sc2, g2 = ada_mod(c, ada_w[l], ada_b[l], 6)
        h = modulate(rms_norm(x, norm_g[l, 0]), sh1, sc1)
        if l < N_A_LAYERS:
            out, nbuf, h_last = recurrent_block(h, rnn_w_in[l], rnn_conv_w[l], rnn_conv_b[l],
                                                rnn_gate_w[l], rnn_gate_b[l], rnn_lambda[l],
                                                rnn_w_out[l], conv_bufs[l], h0s[l])
            new_conv.append(nbuf)
            new_h.append(h_last)
        else:
            j = l - N_A_LAYERS
            q = apply_partial_rope((h @ attn_w_q[j]).reshape(B, T, N_HEADS, HEAD_DIM), pos)
            out = sliding_sink_attention(q, k_all, v_all, attn_sinks[j], p0) @ attn_w_o[j]
        x = x + g1[:, None, :] * out
        h = modulate(rms_norm(x, norm_g[l, 1]), sh2, sc2)
        x = x + g2[:, None, :] * swiglu(h, ffn_w_in[l], ffn_w_out[l])
        if l == N_A_LAYERS - 1:
            kv_shift, kv_scale = ada_mod(c, kv_ada_w, kv_ada_b, 2)
            hk = modulate(rms_norm(x, kv_norm_g), kv_shift, kv_scale)
            kv = (hk @ w_kv).reshape(B, T, 2, N_KV_HEADS, HEAD_DIM)
            k_new = apply_partial_rope(kv[:, :, 0], pos)
            k_all = jnp.concatenate([k_prev.astype(x.dtype), k_new], axis=1)
            v_all = jnp.concatenate([v_prev.astype(x.dtype), kv[:, :, 1]], axis=1)
    y = rms_norm(x, final_g)
    L = k_all.shape[1]
    return y, jnp.stack(new_conv), jnp.stack(new_h), k_all[:, L - WINDOW:], v_all[:, L - WINDOW:]


def setup_inputs(seed: int = 0) -> dict:
    key = jax.random.key(seed)
    ks = iter(jax.random.split(key, 32))
    f32 = jnp.float32
    D = D_MODEL

    def nrm(shape, scale):
        return jax.random.normal(next(ks), shape, f32) * scale

    u = jax.random.uniform(next(ks), (N_A_LAYERS, D_RNN), f32, 0.9, 0.999)
    a0 = u ** (1.0 / RG_C)
    rnn_lambda = jnp.log(a0) - jnp.log1p(-a0)
    return {
        'x_prompt': nrm((BATCH, SEQ, D), 1.0),
        'x_sample': nrm((DEC_BATCH, DEC_SEQ, D), 1.0),
        'c_prompt': nrm((BATCH, D), 1.0),
        'c_sample': nrm((DEC_BATCH, D), 1.0),
        'state_conv': nrm((N_A_LAYERS, DEC_BATCH, CONV_WIDTH - 1, D_RNN), 1.0),
        'state_h': nrm((N_A_LAYERS, DEC_BATCH, D_RNN), 0.5),
        'cache_k': nrm((DEC_BATCH, WINDOW, N_KV_HEADS, HEAD_DIM), 1.0),
        'cache_v': nrm((DEC_BATCH, WINDOW, N_KV_HEADS, HEAD_DIM), 1.0),
        'ada_w': nrm((DEPTH, D, 6 * D), 0.5 * D ** -0.5),
        'ada_b': nrm((DEPTH, 6 * D), 0.05),
        'norm_g': 1.0 + nrm((DEPTH, 2, D), 0.02),
        'rnn_w_in': nrm((N_A_LAYERS, D, 2 * D_RNN), D ** -0.5),
        'rnn_conv_w': nrm((N_A_LAYERS, CONV_WIDTH, D_RNN), CONV_WIDTH ** -0.5),
        'rnn_conv_b': nrm((N_A_LAYERS, D_RNN), 0.02),
        'rnn_gate_w': nrm((N_A_LAYERS, N_RNN_BLOCKS, RNN_BLOCK, 2 * RNN_BLOCK), RNN_BLOCK ** -0.5),
        'rnn_gate_b': nrm((N_A_LAYERS, N_RNN_BLOCKS, 2 * RNN_BLOCK), 0.1),
        'rnn_lambda': rnn_lambda,
        'rnn_w_out': nrm((N_A_LAYERS, D_RNN, D), D_RNN ** -0.5),
        'kv_ada_w': nrm((D, 2 * D), 0.5 * D ** -0.5),
        'kv_ada_b': nrm((2 * D,), 0.05),
        'kv_norm_g': 1.0 + nrm((D,), 0.02),
        'w_kv': nrm((D, 2 * N_KV_HEADS * HEAD_DIM), D ** -0.5),
        'attn_w_q': nrm((N_B_LAYERS, D, N_HEADS * HEAD_DIM), D ** -0.5),
        'attn_sinks': nrm((N_B_LAYERS, N_HEADS), 1.0),
        'attn_w_o': nrm((N_B_LAYERS, N_HEADS * HEAD_DIM, D), (N_HEADS * HEAD_DIM) ** -0.5),
        'ffn_w_in': nrm((DEPTH, D, 2 * D_FF), D ** -0.5),
        'ffn_w_out': nrm((DEPTH, D_FF, D), D_FF ** -0.5),
        'final_g': 1.0 + nrm((D,), 0.02),
    }


def reference(x_prompt, x_sample, c_prompt, c_sample, state_conv, state_h, cache_k, cache_v,
              ada_w, ada_b, norm_g, rnn_w_in, rnn_conv_w, rnn_conv_b, rnn_gate_w, rnn_gate_b,
              rnn_lambda, rnn_w_out, kv_ada_w, kv_ada_b, kv_norm_g, w_kv, attn_w_q, attn_sinks,
              attn_w_o, ffn_w_in, ffn_w_out, final_g):
    params = (ada_w, ada_b, norm_g, rnn_w_in, rnn_conv_w, rnn_conv_b, rnn_gate_w, rnn_gate_b,
              rnn_lambda, rnn_w_out, kv_ada_w, kv_ada_b, kv_norm_g, w_kv, attn_w_q, attn_sinks,
              attn_w_o, ffn_w_in, ffn_w_out, final_g)
    B = x_prompt.shape[0]
    conv0 = jnp.zeros((N_A_LAYERS, B, CONV_WIDTH - 1, D_RNN), x_prompt.dtype)
    h00 = jnp.zeros((N_A_LAYERS, B, D_RNN), jnp.float32)
    kv0 = jnp.zeros((B, WINDOW, N_KV_HEADS, HEAD_DIM), x_prompt.dtype)
    y_prompt, prompt_conv, prompt_h, prompt_k, prompt_v = trunk(
        x_prompt, c_prompt, 0, conv0, h00, kv0, kv0, params)
    y_sample, sample_conv, sample_h, sample_k, sample_v = trunk(
        x_sample, c_sample, PAST_LEN, state_conv, state_h, cache_k, cache_v, params)
    return (y_prompt, y_sample, prompt_conv, prompt_h, prompt_k, prompt_v,
            sample_conv, sample_h, sample_k, sample_v)
```

```cpp
#include <hip/hip_runtime.h>
#include <cstdio>
#include <cstdint>
#include <cmath>

constexpr int DM = 1024;
constexpr int MP = 16384, MS = 1024, MT = MP + MS;
constexpr int NCOND = 136;
constexpr int FF = 2816, NMOD = 14336;
constexpr float EPS = 1e-6f;
constexpr float QSCALE = 0.125f * 1.4426950408889634f;
constexpr size_t O_Y = 0, O_PCONV = 17825792, O_PH = 17850368, O_PK = 17858560, O_PV = 18120704, O_SCONV = 18382848, O_SH = 18776064, O_SK = 18907136, O_SV = 23101440, O_END = 27295744;
__device__ __forceinline__ int cond_row(int r) { return r < MP ? (r >> 11) : 8 + ((r - MP) >> 3); }

namespace pg8 {
#define PG8_LAS __attribute__((address_space(3)))
typedef unsigned short bf16_t;
typedef short bf16x8 __attribute__((ext_vector_type(8)));
typedef float f32x4 __attribute__((ext_vector_type(4)));
typedef unsigned u32x4 __attribute__((ext_vector_type(4)));
constexpr int BM = 256, BK = 64, HALF = 128, HTB = HALF * BK * 2  , STAGE_BYTES = 8 * HTB, NXCD = 8, WGM = 8;

__host__ __device__ __forceinline__ int lds_byte(int r, int c) { const int st = (r >> 4) * 2 + (c >> 5), rr = r & 15, cc = c & 31, ob = rr * 64 + cc * 2; return st * 1024 + (ob ^ (((ob >> 9) & 1) << 5)); }
__host__ __device__ __forceinline__ void stage_rc(int b, int& R, int& C) { const int st = b / 1024, sb = b % 1024, swz = sb ^ (((sb >> 9) & 1) << 5); R = (st >> 1) * 16 + swz / 64; C = (st & 1) * 32 + (swz % 64) / 2; }
__host__ __device__ __forceinline__ int perm32(int rho) { const int n = rho >> 4, i = rho & 15; return 8 * (i >> 2) + 4 * n + (i & 3); }

struct Unit { int pm, pn; };
struct Gemm { const bf16_t* A; const bf16_t* A2; int pn_split; const bf16_t* Bt; int M, N, K; };

struct StaticOrder {
    int nM, nN, nwg, G, c;
    __host__ __device__ void init(int M, int N, int G_, int c_) { nM = M / BM; nN = N / BM; nwg = nM * nN; G = G_; c = c_; }
    __host__ __device__ bool next(int i, Unit& u) const {
        const long L = (long)i * G + c; if (L >= nwg) return false;
        int wgid = (int)L; { const int q = nwg / NXCD, r = nwg % NXCD, xcd = wgid % NXCD, off = wgid / NXCD; wgid = (xcd < r ? xcd * (q + 1) : r * (q + 1) + (xcd - r) * q) + off; }
        const int nig = WGM * nN, gid = wgid / nig, fm = gid * WGM, gsz = (nM - fm) < WGM ? (nM - fm) : WGM;
        u.pm = fm + ((wgid % nig) % gsz); u.pn = (wgid % nig) / gsz; return true;
    }
    __device__ __forceinline__ void a_ready(const Unit&) const {}
    __device__ __forceinline__ void done(const Unit&) const {}
};

__device__ __forceinline__ unsigned cvt_pk_bf16(float lo, float hi) { unsigned r; asm volatile("v_cvt_pk_bf16_f32 %0, %1, %2" : "=v"(r) : "v"(lo), "v"(hi)); return r; }
typedef float f32x2 __attribute__((ext_vector_type(2)));

typedef unsigned u32x2 __attribute__((ext_vector_type(2)));
__device__ __forceinline__ float fast_sigmoid(float x) { return __builtin_amdgcn_rcpf(1.0f + __builtin_amdgcn_exp2f(-1.4426950408889634f * x)); }

struct EpiAda {
    static constexpr bool PERM = false, AFTER_DRAIN = false;
    float* C; const float* b0; const float* b1;
    __device__ __forceinline__ void operator()(const f32x4 (&acc)[2][2][4][2], const Unit& u, int wr, int wc, int fr, int fq) const {
        const int row0 = u.pm * BM + wr * 64 + fr, col0 = u.pn * BM + wc * 32 + 4 * fq;
        const float* bias = (u.pn < 48) ? (b0 + col0) : (b1 + (col0 - 12288));
        f32x4 bv[2][2];
#pragma unroll
        for (int bj = 0; bj < 2; ++bj)
#pragma unroll
            for (int n = 0; n < 2; ++n) bv[bj][n] = *(const f32x4*)(bias + bj * HALF + n * 16);
#pragma unroll
        for (int ai = 0; ai < 2; ++ai)
#pragma unroll
            for (int m = 0; m < 4; ++m) { float* rowp = C + (size_t)(row0 + ai * HALF + m * 16) * NMOD + col0;
#pragma unroll
                for (int bj = 0; bj < 2; ++bj)
#pragma unroll
                    for (int n = 0; n < 2; ++n) *(f32x4*)(rowp + bj * HALF + n * 16) = acc[ai][bj][m][n] + bv[bj][n]; }
    }
};

struct EpiBf16x2 {
    static constexpr bool PERM = true, AFTER_DRAIN = false;
    bf16_t* O0; bf16_t* O1;
    __device__ __forceinline__ void operator()(const f32x4 (&acc)[2][2][4][2], const Unit& u, int wr, int wc, int fr, int fq) const {
        const int row0 = u.pm * BM + wr * 64 + fr; int colt = u.pn * BM; bf16_t* base = O0;
        if (colt >= DM) { base = O1; colt -= DM; }
        const int col0 = colt + wc * 32 + 8 * fq;
#pragma unroll
        for (int ai = 0; ai < 2; ++ai)
#pragma unroll
            for (int m = 0; m < 4; ++m) { bf16_t* rowp = base + (size_t)(row0 + ai * HALF + m * 16) * DM + col0;
#pragma unroll
                for (int bj = 0; bj < 2; ++bj) { const f32x4 v0 = acc[ai][bj][m][0], v1 = acc[ai][bj][m][1];
                    u32x4 w; w.x = cvt_pk_bf16(v0[0], v0[1]); w.y = cvt_pk_bf16(v0[2], v0[3]); w.z = cvt_pk_bf16(v1[0], v1[1]); w.w = cvt_pk_bf16(v1[2], v1[3]);
                    *(u32x4*)(rowp + bj * HALF) = w; } }
    }
};

struct EpiResGate {
    static constexpr bool PERM = false, AFTER_DRAIN = false;
    const float* base_p; const float* base_s; float* out; const float* mods; int goff;
    __device__ __forceinline__ void operator()(const f32x4 (&acc)[2][2][4][2], const Unit& u, int wr, int wc, int fr, int fq) const {
        const int col0 = u.pn * BM + wc * 32 + 4 * fq;
#pragma unroll
        for (int ai = 0; ai < 2; ++ai)
#pragma unroll
            for (int m = 0; m < 4; ++m) {
                const int r = u.pm * BM + ai * HALF + wr * 64 + m * 16 + fr;
                const float* bp = (r < MP) ? (base_p + (size_t)r * DM) : (base_s + (size_t)(r - MP) * DM);
                const float* gp = mods + (size_t)cond_row(r) * NMOD + goff;
                float* op = out + (size_t)r * DM;
#pragma unroll
                for (int bj = 0; bj < 2; ++bj)
#pragma unroll
                    for (int n = 0; n < 2; ++n) { const int c = col0 + bj * HALF + n * 16;
                        const f32x4 b = *(const f32x4*)(bp + c), g = *(const f32x4*)(gp + c);
                        *(f32x4*)(op + c) = b + g * acc[ai][bj][m][n]; }
                asm volatile("" ::: "memory");
            }
    }
};

struct EpiSwiGLU {
    static constexpr bool PERM = true, AFTER_DRAIN = false;
    bf16_t* O;
    __device__ __forceinline__ void operator()(const f32x4 (&acc)[2][2][4][2], const Unit& u, int wr, int wc, int fr, int fq) const {
        const int row0 = u.pm * BM + wr * 64 + fr, col0 = u.pn * HALF + wc * 32 + 8 * fq;
#pragma unroll
        for (int ai = 0; ai < 2; ++ai)
#pragma unroll
            for (int m = 0; m < 4; ++m) { bf16_t* rowp = O + (size_t)(row0 + ai * HALF + m * 16) * FF + col0;
                f32x4 o0, o1;
#pragma unroll
                for (int e = 0; e < 4; ++e) { const float g0 = acc[ai][0][m][0][e], g1 = acc[ai][0][m][1][e];
                    o0[e] = g0 * fast_sigmoid(g0) * acc[ai][1][m][0][e]; o1[e] = g1 * fast_sigmoid(g1) * acc[ai][1][m][1][e]; }
                u32x4 w; w.x = cvt_pk_bf16(o0[0], o0[1]); w.y = cvt_pk_bf16(o0[2], o0[3]); w.z = cvt_pk_bf16(o1[0], o1[1]); w.w = cvt_pk_bf16(o1[2], o1[3]);
                *(u32x4*)rowp = w; }
    }
};

struct EpiKVQ {
    static constexpr bool PERM = true, AFTER_DRAIN = false;
    bf16_t* KB; bf16_t* VB; bf16_t* QB; const float* rope; float* dout;
    __device__ __forceinline__ void operator()(const f32x4 (&acc)[2][2][4][2], const Unit& u, int wr, int wc, int fr, int fq) const {
        const int tile = u.pn, cl = wc * 32 + 8 * fq;
        const bool rot_wave = (tile != 1) && ((wc & 1) == 0);
        const float sg = (fq == 0) ? -1.f : 1.f;
#pragma unroll
        for (int ai = 0; ai < 2; ++ai)
#pragma unroll
            for (int m = 0; m < 4; ++m) {
                const int r = u.pm * BM + ai * HALF + wr * 64 + m * 16 + fr;
                const bool samp = r >= MP;
                const int pidx = samp ? (2048 + ((r - MP) & 7)) : (r & 2047);
                f32x4 cs0 = {1.f, 1.f, 1.f, 1.f}, cs1 = cs0, sn0 = {0.f, 0.f, 0.f, 0.f}, sn1 = sn0;
                if (rot_wave) { const float* rp = rope + (size_t)pidx * 16; cs0 = *(const f32x4*)rp; cs1 = *(const f32x4*)(rp + 4); sn0 = *(const f32x4*)(rp + 8); sn1 = *(const f32x4*)(rp + 12); }
#pragma unroll
                for (int bj = 0; bj < 2; ++bj) {
                    f32x4 v0 = acc[ai][bj][m][0], v1 = acc[ai][bj][m][1];
                    if (rot_wave) {
                        f32x4 o0, o1;
#pragma unroll
                        for (int e = 0; e < 4; ++e) { o0[e] = __shfl_xor(v0[e], 16); o1[e] = __shfl_xor(v1[e], 16); }
                        if (fq < 2) { v0 = v0 * cs0 + (o0 * sg) * sn0; v1 = v1 * cs1 + (o1 * sg) * sn1; }
                    }
                    const int c = bj * HALF + cl;
                    if (tile < 2) {
                        bf16_t* dst = (tile == 0 ? KB : VB) + (size_t)r * 256 + c;
                        u32x4 w; w.x = cvt_pk_bf16(v0[0], v0[1]); w.y = cvt_pk_bf16(v0[2], v0[3]); w.z = cvt_pk_bf16(v1[0], v1[1]); w.w = cvt_pk_bf16(v1[2], v1[3]);
                        *(u32x4*)dst = w;
                        if (samp) { const int bs = (r - MP) >> 3, ts = (r - MP) & 7;
                            float* wp = dout + (tile == 0 ? O_SK : O_SV) + ((size_t)bs * 128 + 120 + ts) * 256 + c;
                            *(f32x4*)wp = v0; *(f32x4*)(wp + 4) = v1;
                        } else if ((r & 2047) >= 1920) { const int b = r >> 11, j = (r & 2047) - 1920;
                            float* wp = dout + (tile == 0 ? O_PK : O_PV) + ((size_t)b * 128 + j) * 256 + c;
                            *(f32x4*)wp = v0; *(f32x4*)(wp + 4) = v1;
                        }
                    } else {
                        v0 = v0 * QSCALE; v1 = v1 * QSCALE;
                        bf16_t* dst = QB + (size_t)r * DM + (tile - 2) * BM + c;
                        u32x4 w; w.x = cvt_pk_bf16(v0[0], v0[1]); w.y = cvt_pk_bf16(v0[2], v0[3]); w.z = cvt_pk_bf16(v1[0], v1[1]); w.w = cvt_pk_bf16(v1[2], v1[3]);
                        *(u32x4*)dst = w;
                    }
                }
            }
    }
};

template <class Epi, class Sched, bool ALIGN_EPI = false, bool SP2 = false>
__device__ __forceinline__ void gemm_phase(PG8_LAS unsigned char* lds, const Gemm g, const Sched& S, const Epi& E) {
    const int tid = threadIdx.x, wid = __builtin_amdgcn_readfirstlane(tid >> 6), lane = tid & 63, wr = wid >> 2, wc = wid & 3, fr = lane & 15, fq = lane >> 4;
    const int K = g.K, nt = K / BK;
    unsigned voffA[2], voffB[2];
#pragma unroll
    for (int i = 0; i < 2; ++i) { int R, C; stage_rc(tid * 16 + i * 8192, R, C); const int Rb = Epi::PERM ? ((R & ~31) + perm32(R & 31)) : R;
        voffA[i] = (unsigned)(R * K + C) * 2u; voffB[i] = (unsigned)(Rb * K + C) * 2u; }
    const size_t kstep = (size_t)(BK * 2);
    const size_t hstep = (size_t)HALF * K * 2;
    const size_t tstep = 2 * hstep;
    const unsigned ldsw = (unsigned)wid * 1024u;
    const int aoff = lds_byte(wr * 64 + fr, fq * 8), boff = lds_byte(wc * 32 + fr, fq * 8);
#define PG8_SA(b, h) (((b) * 2 + (h)) * HTB)
#define PG8_SB(b, h) ((4 + (b) * 2 + (h)) * HTB)
#define PG8_STAGE(bufoff, gbase, voff) do { _Pragma("unroll") for (int _i = 0; _i < 2; ++_i) \
        __builtin_amdgcn_global_load_lds((const unsigned*)((const char*)(gbase) + (voff)[_i]), (PG8_LAS unsigned*)(lds + (bufoff) + ldsw + _i * 8192), 16, 0, 0); } while (0)
#define PG8_LDA(dst, b, h) do { _Pragma("unroll") for (int m = 0; m < 4; ++m) _Pragma("unroll") for (int k = 0; k < 2; ++k) dst[m][k] = *(const PG8_LAS bf16x8*)(lds + PG8_SA(b, h) + aoff + m * 2048 + k * 1024); } while (0)
#define PG8_LDB(dst, b, h) do { _Pragma("unroll") for (int n = 0; n < 2; ++n) _Pragma("unroll") for (int k = 0; k < 2; ++k) dst[n][k] = *(const PG8_LAS bf16x8*)(lds + PG8_SB(b, h) + boff + n * 2048 + k * 1024); } while (0)
#define PG8_MMA(ai, bj, At, Bt) do { __builtin_amdgcn_s_setprio(1); _Pragma("unroll") for (int m = 0; m < 4; ++m) _Pragma("unroll") for (int n = 0; n < 2; ++n) _Pragma("unroll") for (int k = 0; k < 2; ++k) \
        acc[ai][bj][m][n] = __builtin_amdgcn_mfma_f32_16x16x32_bf16(Bt[n][k], At[m][k], acc[ai][bj][m][n], 0, 0, 0); __builtin_amdgcn_s_setprio(0); } while (0)
#define PG8_WAIT_V(n) asm volatile("s_waitcnt vmcnt(" #n ")" ::: "memory")
#define PG8_WAIT_L(n) asm volatile("s_waitcnt lgkmcnt(" #n ")" ::: "memory")
#define PG8_BAR __builtin_amdgcn_s_barrier()
#define PG8_SCHED __builtin_amdgcn_sched_barrier(0)
    Unit cur, nxt; int ui = 0;
    if (!S.next(0, cur)) return;
    f32x4 acc[2][2][4][2];
#pragma unroll
    for (int a = 0; a < 2; ++a)
#pragma unroll
        for (int b = 0; b < 2; ++b)
#pragma unroll
            for (int m = 0; m < 4; ++m)
#pragma unroll
                for (int n = 0; n < 2; ++n) acc[a][b][m][n] = (f32x4){0.f, 0.f, 0.f, 0.f};
    bf16x8 At[4][2], B0[2][2], B1[2][2];
    const char* cA = (const char*)(cur.pn < g.pn_split ? g.A : g.A2) + (size_t)cur.pm * tstep; const char* cB = (const char*)g.Bt + (size_t)cur.pn * tstep;
    S.a_ready(cur);
    if constexpr (SP2) {
        PG8_STAGE(PG8_SB(0, 0), cB, voffB); PG8_STAGE(PG8_SB(0, 1), cB + hstep, voffB); PG8_STAGE(PG8_SA(0, 0), cA, voffA); PG8_STAGE(PG8_SA(0, 1), cA + hstep, voffA);
        if (wr == 1) PG8_BAR;
        PG8_WAIT_V(2); PG8_BAR;
        PG8_STAGE(PG8_SB(1, 0), cB + kstep, voffB); PG8_STAGE(PG8_SA(1, 0), cA + kstep, voffA); PG8_STAGE(PG8_SB(1, 1), cB + hstep + kstep, voffB);
        PG8_WAIT_V(6); PG8_BAR;
    } else {
        PG8_STAGE(PG8_SB(0, 0), cB, voffB); PG8_STAGE(PG8_SA(0, 0), cA, voffA); PG8_STAGE(PG8_SB(0, 1), cB + hstep, voffB); PG8_STAGE(PG8_SA(0, 1), cA + hstep, voffA);
        if (wr == 1) PG8_BAR;
        PG8_WAIT_V(4); PG8_BAR;
        PG8_STAGE(PG8_SB(1, 0), cB + kstep, voffB); PG8_STAGE(PG8_SA(1, 0), cA + kstep, voffA); PG8_STAGE(PG8_SB(1, 1), cB + hstep + kstep, voffB);
        PG8_WAIT_V(6); PG8_BAR;
    }
    for (;;) {
        const bool has_next = S.next(ui + 1, nxt);
        const char* nA = has_next ? (const char*)(nxt.pn < g.pn_split ? g.A : g.A2) + (size_t)nxt.pm * tstep : cA; const char* nB = has_next ? (const char*)g.Bt + (size_t)nxt.pn * tstep : cB;
        for (int t = 0; t < nt; t += 2) {
            const bool last = (t == nt - 2);
            const char* a1 = cA + (size_t)(t + 1) * kstep;
            const char* a2 = last ? nA : cA + (size_t)(t + 2) * kstep; const char* b2 = last ? nB : cB + (size_t)(t + 2) * kstep;
            const char* a3 = a2 + kstep; const char* b3 = b2 + kstep;
            if (last && has_next) S.a_ready(nxt);
            if constexpr (SP2) {
            PG8_LDB(B0, 0, 0); PG8_LDB(B1, 0, 1); PG8_SCHED; PG8_LDA(At, 0, 0); PG8_STAGE(PG8_SA(1, 1), a1 + hstep, voffA);
            PG8_WAIT_V(8); PG8_WAIT_L(0); PG8_BAR; PG8_MMA(0, 0, At, B0); PG8_MMA(0, 1, At, B1); PG8_BAR; PG8_SCHED;
            PG8_LDA(At, 0, 1); PG8_STAGE(PG8_SB(0, 0), b2, voffB); PG8_STAGE(PG8_SB(0, 1), b2 + hstep, voffB); PG8_STAGE(PG8_SA(0, 0), a2, voffA);
            PG8_WAIT_V(8); PG8_WAIT_L(0); PG8_BAR; PG8_MMA(1, 0, At, B0); PG8_MMA(1, 1, At, B1); PG8_BAR; PG8_SCHED;
            PG8_LDB(B0, 1, 0); PG8_LDB(B1, 1, 1); PG8_SCHED; PG8_LDA(At, 1, 0); PG8_STAGE(PG8_SA(0, 1), a2 + hstep, voffA);
            PG8_WAIT_V(8); PG8_WAIT_L(0); PG8_BAR; PG8_MMA(0, 0, At, B0); PG8_MMA(0, 1, At, B1); PG8_BAR; PG8_SCHED;
            PG8_LDA(At, 1, 1); PG8_STAGE(PG8_SB(1, 0), b3, voffB); PG8_STAGE(PG8_SB(1, 1), b3 + hstep, voffB); PG8_STAGE(PG8_SA(1, 0), a3, voffA);
            PG8_WAIT_V(8); PG8_WAIT_L(0); PG8_BAR; PG8_MMA(1, 0, At, B0); PG8_MMA(1, 1, At, B1); PG8_BAR; PG8_SCHED;
            } else {
            PG8_LDB(B0, 0, 0); PG8_SCHED; PG8_LDA(At, 0, 0); PG8_STAGE(PG8_SA(1, 1), a1 + hstep, voffA);
            PG8_WAIT_L(8); PG8_BAR; PG8_WAIT_L(0); PG8_MMA(0, 0, At, B0); PG8_BAR; PG8_SCHED;
            PG8_LDB(B1, 0, 1); PG8_STAGE(PG8_SB(0, 0), b2, voffB);
            PG8_BAR; PG8_WAIT_L(0); PG8_MMA(0, 1, At, B1); PG8_BAR;
            PG8_LDA(At, 0, 1); PG8_STAGE(PG8_SA(0, 0), a2, voffA);
            PG8_BAR; PG8_WAIT_L(0); PG8_MMA(1, 0, At, B0); PG8_BAR; PG8_SCHED;
            PG8_STAGE(PG8_SB(0, 1), b2 + hstep, voffB);
            PG8_WAIT_V(6); PG8_BAR; PG8_MMA(1, 1, At, B1); PG8_BAR;
            PG8_LDB(B0, 1, 0); PG8_SCHED; PG8_LDA(At, 1, 0); PG8_STAGE(PG8_SA(0, 1), a2 + hstep, voffA);
            PG8_WAIT_L(8); PG8_BAR; PG8_WAIT_L(0); PG8_MMA(0, 0, At, B0); PG8_BAR; PG8_SCHED;
            PG8_LDB(B1, 1, 1); PG8_STAGE(PG8_SB(1, 0), b3, voffB);
            PG8_BAR; PG8_WAIT_L(0); PG8_MMA(0, 1, At, B1); PG8_BAR;
            PG8_LDA(At, 1, 1); PG8_STAGE(PG8_SA(1, 0), a3, voffA);
            PG8_BAR; PG8_WAIT_L(0); PG8_MMA(1, 0, At, B0); PG8_BAR; PG8_SCHED;
            PG8_STAGE(PG8_SB(1, 1), b3 + hstep, voffB);
            PG8_WAIT_V(6); PG8_BAR; PG8_MMA(1, 1, At, B1); PG8_BAR;
            }
        }
        if constexpr (ALIGN_EPI) { if (wr == 0) PG8_BAR; }
        if constexpr (!Epi::AFTER_DRAIN) { E(acc, cur, wr, wc, fr, fq); S.done(cur); }
        if (!has_next) break;
#pragma unroll
        for (int a = 0; a < 2; ++a)
#pragma unroll
            for (int b = 0; b < 2; ++b)
#pragma unroll
                for (int m = 0; m < 4; ++m)
#pragma unroll
                    for (int n = 0; n < 2; ++n) acc[a][b][m][n] = (f32x4){0.f, 0.f, 0.f, 0.f};
        cur = nxt; cA = nA; cB = nB; ++ui;
        if constexpr (ALIGN_EPI) { if (wr == 1) PG8_BAR; }
    }
    PG8_WAIT_V(0);
    if constexpr (!ALIGN_EPI) { if (wr == 0) PG8_BAR; }
    PG8_BAR;
    if constexpr (Epi::AFTER_DRAIN) { E.fused(acc, cur, wr, wc, fr, fq, lds, wid, lane); S.done(cur); }
#undef PG8_SA
#undef PG8_SB
#undef PG8_STAGE
#undef PG8_LDA
#undef PG8_LDB
#undef PG8_MMA
#undef PG8_WAIT_V
#undef PG8_WAIT_L
#undef PG8_BAR
#undef PG8_SCHED
}
}

#define GAS __attribute__((address_space(1)))
#define LAS __attribute__((address_space(3)))
typedef unsigned short bf16;
typedef unsigned v4u __attribute__((ext_vector_type(4)));
typedef float f32x4 __attribute__((ext_vector_type(4)));
typedef short bf16x8 __attribute__((ext_vector_type(8)));
typedef GAS unsigned gu32;
typedef GAS unsigned long long gu64;
#define RLX_AGENT __ATOMIC_RELAXED, __HIP_MEMORY_SCOPE_AGENT
#define LDS_WAIT() asm volatile("s_waitcnt lgkmcnt(0)" ::: "memory")
#define VM_WAIT() asm volatile("s_waitcnt vmcnt(0)" ::: "memory")
__device__ __forceinline__ unsigned long long rt() { return __builtin_amdgcn_s_memrealtime(); }
__device__ __forceinline__ unsigned f2bf(float f) { unsigned u = __builtin_bit_cast(unsigned, f); return (u + 0x7fffu + ((u >> 16) & 1u)) >> 16; }
__device__ __forceinline__ unsigned pk2(float lo, float hi) { return f2bf(lo) | (f2bf(hi) << 16); }

#define XB_TMO      128
#define XB_XCNT(j)  (256  + 64 * (j))
#define XB_XSUB(j)  (1280 + 64 * (j))
#define XB_XGEN(j)  (2304 + 64 * (j))
#define XB_TOP      3328
#define XB_TOPGEN   3392
#define XCD_BAR_WORDS 3456
#define XB_SPIN_CAP (1u << 18)

__device__ __forceinline__ unsigned xb_ld(unsigned* p)              { return __hip_atomic_load(p, __ATOMIC_RELAXED, __HIP_MEMORY_SCOPE_AGENT); }
__device__ __forceinline__ unsigned xb_add(unsigned* p, unsigned v) { return __hip_atomic_fetch_add(p, v, __ATOMIC_RELAXED, __HIP_MEMORY_SCOPE_AGENT); }
__device__ __forceinline__ unsigned xb_xcc_id() { return (unsigned)__builtin_amdgcn_s_getreg((3 << 11) | 20) & 0xFu; }
#define XB_SPIN(cond, bar) do { unsigned _sp = 0; while (cond) { __builtin_amdgcn_s_sleep(1); \
    if ((++_sp & 255u) == 0u) { if (xb_ld(&(bar)[XB_TMO])) break; if (_sp > XB_SPIN_CAP) { atomicAdd(&(bar)[XB_TMO], 1u); break; } } } } while (0)

struct XcdBarrier {
    unsigned* bar; unsigned x;
    volatile LAS unsigned* st;
};

__device__ __forceinline__ XcdBarrier xcd_barrier_post(unsigned* bar, volatile LAS unsigned* st) {
    XcdBarrier b; b.bar = bar; b.x = xb_xcc_id(); b.st = st;
    if (threadIdx.x == 0) (void)xb_add(&bar[XB_XCNT(b.x)], 1u);
    return b;
}
__device__ __forceinline__ void xcd_barrier_complete(unsigned* bar, unsigned x, unsigned& nloc, unsigned& nx) {
    const unsigned G = gridDim.x * gridDim.y * gridDim.z;
    unsigned sum, cnt, mine, sp = 0u;
    for (;;) {
        sum = 0u; cnt = 0u; mine = 0u;
#pragma unroll
        for (unsigned j = 0; j < 16; ++j) { const unsigned c = xb_ld(&bar[XB_XCNT(j)]); sum += c; cnt += (c > 0u) ? 1u : 0u; mine = (j == x) ? c : mine; }
        if (sum == G) break;
        __builtin_amdgcn_s_sleep(1);
        if ((++sp & 255u) == 0u) { if (xb_ld(&bar[XB_TMO])) break; if (sp > XB_SPIN_CAP) { atomicAdd(&bar[XB_TMO], 1u); break; } }
    }
    nloc = mine > 0u ? mine : 1u; nx = cnt > 0u ? cnt : 1u;
}

__device__ __forceinline__ void xcd_barrier(const XcdBarrier& b) {
    asm volatile("s_waitcnt vmcnt(0)" ::: "memory");
    __syncthreads();
    if (threadIdx.x == 0) {
        unsigned* bar = b.bar;
        __builtin_amdgcn_s_waitcnt(0);
        unsigned nloc = b.st[0], nx = b.st[1];
        if (nloc == 0u) { xcd_barrier_complete(bar, b.x, nloc, nx); b.st[0] = nloc; b.st[1] = nx; }
        const unsigned old = xb_add(&bar[XB_XSUB(b.x)], 1u);
        const unsigned gen = old / nloc;
        if (old + 1u == (gen + 1u) * nloc) {
            __builtin_amdgcn_fence(__ATOMIC_RELEASE, "agent");
            asm volatile("s_waitcnt vmcnt(0)" ::: "memory");
            const unsigned og = xb_add(&bar[XB_TOP], 1u);
            const unsigned tg = og / nx;
            if (og + 1u == (tg + 1u) * nx) xb_add(&bar[XB_TOPGEN], 1u);
            else XB_SPIN(xb_ld(&bar[XB_TOPGEN]) == tg, bar);
            __builtin_amdgcn_fence(__ATOMIC_ACQUIRE, "agent");
            xb_add(&bar[XB_XGEN(b.x)], 1u);
            asm volatile("s_waitcnt vmcnt(0)" ::: "memory");
        } else {
            XB_SPIN(xb_ld(&bar[XB_XGEN(b.x)]) == gen, bar);
            __builtin_amdgcn_fence(__ATOMIC_ACQUIRE, "agent");
            asm volatile("s_waitcnt vmcnt(0)" ::: "memory");
        }
    }
    __syncthreads();
}

constexpr size_t MiB = 1u << 20;
constexpr size_t WS_CTL = 0, CTL_ZERO_BYTES = 1 * MiB;
constexpr size_t WS_ROPE = 1 * MiB;
constexpr size_t WS_WGF = 1 * MiB + 256 * 1024;
constexpr size_t WS_SC = 2 * MiB;
constexpr size_t WS_MODS = 3 * MiB;
constexpr size_t WS_WADA = 17 * MiB, WS_WIN = 45 * MiB, WS_WOUT = 49 * MiB, WS_WKVQ = 51 * MiB, WS_WO = 54 * MiB, WS_WFI = 56 * MiB, WS_WFO = 78 * MiB;
constexpr size_t WFI_BYTES = 11 * MiB, WFO_BYTES = 5 * MiB + 512 * 1024;
constexpr size_t WS_C = 89 * MiB;
constexpr size_t WS_B = 123 * MiB;
constexpr size_t ACT_ROWS_BYTES = (size_t)MT * DM * 2;
constexpr size_t WS_XR = WS_B, WS_YG = WS_B + ACT_ROWS_BYTES, WS_ACT = WS_B;
constexpr size_t WS_HK = WS_B, WS_Q = WS_B + ACT_ROWS_BYTES, WS_K = WS_B + 2 * ACT_ROWS_BYTES, WS_V = WS_K + (size_t)MT * 256 * 2;
constexpr size_t WS_END = WS_B + (size_t)MT * FF * 2;
static_assert(WS_V + (size_t)MT * 256 * 2 <= WS_END && WS_END <= 256 * MiB && WS_WFO + 2 * WFO_BYTES <= WS_C && WS_C + ACT_ROWS_BYTES <= WS_B, "d_ws map");
constexpr int CW_BAR = 4096;

constexpr int RING_OFF = 0, RING_BYTES = 131072;
constexpr int LDSCTL_OFF = RING_BYTES, MISC_OFF = LDSCTL_OFF + 320;
constexpr int LDS_BYTES = 147456;
constexpr int NWAVES = 8, NPHASE = 17;

struct Args { const float* in[28]; float* out; unsigned char* ws; int ph_lo, ph_hi; float inv[8]; };

struct Frame {
    LAS unsigned char* lds;
    int tid, lane, wave, G, bx;
};

__device__ __forceinline__ float wave_sum(float v) {
#pragma unroll
    for (int o = 1; o < 64; o <<= 1) v += __shfl_xor(v, o);
    return v;
}
__device__ __forceinline__ float fast_sig(float x) { return __builtin_amdgcn_rcpf(1.0f + __builtin_amdgcn_exp2f(-1.4426950408889634f * x)); }
__device__ __forceinline__ float bf2f(unsigned short h) { return __builtin_bit_cast(float, (unsigned)h << 16); }
__device__ __forceinline__ float bflo(unsigned w) { return __builtin_bit_cast(float, w << 16); }
__device__ __forceinline__ float bfhi(unsigned w) { return __builtin_bit_cast(float, w & 0xffff0000u); }

__device__ __forceinline__ void p0_transpose_item(const float* W, int K, int N, bf16* WT, int row_off, int mode, LAS float* scr, int item, int lane) {
    const int nblk = N / 32, kb = item / nblk, nb = item % nblk, k0 = 64 * kb, n0 = 32 * nb;
#pragma unroll 8
    for (int i = 0; i < 32; ++i) { const int kk = 2 * i + (lane >> 5); scr[kk * 33 + (lane & 31)] = W[(size_t)(k0 + kk) * N + n0 + (lane & 31)]; }
    LDS_WAIT(); asm volatile("" ::: "memory");
    int d0;
    if (mode == 0) d0 = row_off + n0; else { const int f = n0 < FF ? n0 : n0 - FF; d0 = 256 * (f >> 7) + (f & 127) + (n0 < FF ? 0 : 128); }
    const int c = lane & 7;
#pragma unroll
    for (int j = 0; j < 4; ++j) { const int n = (lane >> 3) + 8 * j; const LAS float* s = scr + (8 * c) * 33 + n;
        v4u o; o.x = pk2(s[0 * 33], s[1 * 33]); o.y = pk2(s[2 * 33], s[3 * 33]); o.z = pk2(s[4 * 33], s[5 * 33]); o.w = pk2(s[6 * 33], s[7 * 33]);
        *(GAS v4u*)(WT + (size_t)(d0 + n) * K + k0 + 8 * c) = o; }
    LDS_WAIT(); asm volatile("" ::: "memory");
}

__device__ __forceinline__ void p0_prologue(Frame& F, const Args& A) {
    LAS float* scr = (LAS float*)(F.lds + RING_OFF + F.wave * 16384);
    const int gw = F.bx * NWAVES + F.wave, NGW = F.G * NWAVES;
    unsigned char* ws = A.ws;
    bf16* WADA = (bf16*)(ws + WS_WADA); bf16* WIN = (bf16*)(ws + WS_WIN); bf16* WOUT = (bf16*)(ws + WS_WOUT); bf16* WKVQ = (bf16*)(ws + WS_WKVQ); bf16* WO = (bf16*)(ws + WS_WO);
    constexpr int I_ADA = 16 * 192, I_KVA = 16 * 64, I_IN = 16 * 64, I_SQ = 16 * 32, I_KV = 16 * 16, I_FI = 16 * 176, I_FO = 44 * 32;
    constexpr int NITEMS = 2 * I_ADA + I_KVA + I_IN + I_SQ + I_KV + I_SQ + I_SQ + 2 * I_FI + 2 * I_FO;
    for (int it = gw; it < NITEMS; it += NGW) {
        int r = it;
        if (r < I_ADA) { p0_transpose_item(A.in[8], 1024, 6144, WADA, 0, 0, scr, r, F.lane); continue; } r -= I_ADA;
        if (r < I_ADA) { p0_transpose_item(A.in[8] + (size_t)1024 * 6144, 1024, 6144, WADA, 6144, 0, scr, r, F.lane); continue; } r -= I_ADA;
        if (r < I_KVA) { p0_transpose_item(A.in[18], 1024, 2048, WADA, 12288, 0, scr, r, F.lane); continue; } r -= I_KVA;
        if (r < I_IN) { p0_transpose_item(A.in[11], 1024, 2048, WIN, 0, 0, scr, r, F.lane); continue; } r -= I_IN;
        if (r < I_SQ) { p0_transpose_item(A.in[17], 1024, 1024, WOUT, 0, 0, scr, r, F.lane); continue; } r -= I_SQ;
        if (r < I_KV) { p0_transpose_item(A.in[21], 1024, 512, WKVQ, 0, 0, scr, r, F.lane); continue; } r -= I_KV;
        if (r < I_SQ) { p0_transpose_item(A.in[22], 1024, 1024, WKVQ, 512, 0, scr, r, F.lane); continue; } r -= I_SQ;
        if (r < I_SQ) { p0_transpose_item(A.in[24], 1024, 1024, WO, 0, 0, scr, r, F.lane); continue; } r -= I_SQ;
        if (r < I_FI) { p0_transpose_item(A.in[25], 1024, 5632, (bf16*)(ws + WS_WFI), 0, 1, scr, r, F.lane); continue; } r -= I_FI;
        if (r < I_FI) { p0_transpose_item(A.in[25] + (size_t)1024 * 5632, 1024, 5632, (bf16*)(ws + WS_WFI + WFI_BYTES), 0, 1, scr, r, F.lane); continue; } r -= I_FI;
        if (r < I_FO) { p0_transpose_item(A.in[26], 2816, 1024, (bf16*)(ws + WS_WFO), 0, 0, scr, r, F.lane); continue; } r -= I_FO;
        p0_transpose_item(A.in[26] + (size_t)2816 * 1024, 2816, 1024, (bf16*)(ws + WS_WFO + WFO_BYTES), 0, 0, scr, r, F.lane);
    }
    const int gt = F.bx * (NWAVES * 64) + F.tid, NGT = F.G * NWAVES * 64;
    { bf16* SC = (bf16*)(ws + WS_SC);
      for (int i = gt; i < 256 * 256; i += NGT) { const int row = i >> 8, c4 = (i & 255) * 4; f32x4 v = {0.f, 0.f, 0.f, 0.f};
          if (row < NCOND) { v = *(const f32x4*)((row < 8 ? A.in[2] + (size_t)row * DM : A.in[3] + (size_t)(row - 8) * DM) + c4);
#pragma unroll
              for (int e = 0; e < 4; ++e) v[e] = v[e] / (1.0f + __expf(-v[e])); }
          uint2 o; o.x = pk2(v[0], v[1]); o.y = pk2(v[2], v[3]); *(uint2*)(SC + (size_t)row * DM + c4) = o; } }
    { v4u* WGF = (v4u*)(ws + WS_WGF);
      for (int i = gt; i < 32 * 16 * 64; i += NGT) { const int ln = i & 63, f = (i >> 6) & 15, mt = f >> 2, ks = f & 3, grp = i >> 10, n = grp >> 2, q = grp & 3, r16 = ln & 15, kq = ln >> 4;
          const int col = (mt >> 1) * 128 + q * 32 + 8 * (r16 >> 2) + (r16 & 3) + 4 * (mt & 1);
          const float* gp = A.in[14] + ((size_t)n * 128 + ks * 32 + kq * 8) * 256 + col;
          v4u o; o.x = pk2(gp[0], gp[256]); o.y = pk2(gp[512], gp[768]); o.z = pk2(gp[1024], gp[1280]); o.w = pk2(gp[1536], gp[1792]); WGF[i] = o; } }
    { float* RT = (float*)(ws + WS_ROPE);
      for (int i = gt; i < 2056 * 8; i += NGT) { const int pi = i >> 3, f = i & 7; const int pos = pi < 2048 ? pi : 16384 + (pi - 2048);
          const float invf = f == 0 ? A.inv[0] : f == 1 ? A.inv[1] : f == 2 ? A.inv[2] : f == 3 ? A.inv[3] : f == 4 ? A.inv[4] : f == 5 ? A.inv[5] : f == 6 ? A.inv[6] : A.inv[7];
          const float ang = (float)pos * invf;
          const double x = (double)ang; const double k = __builtin_rint(x * 0.15915494309189535); const double rr = x - k * 6.283185307179586;
          const double r2 = rr * rr; double ts = rr, tc = 1.0, ss = rr, cc = 1.0;
#pragma unroll 1
          for (int n = 1; n <= 14; ++n) { tc = -tc * r2 / (double)((2 * n - 1) * (2 * n)); ts = -ts * r2 / (double)((2 * n) * (2 * n + 1)); cc += tc; ss += ts; }
          RT[pi * 16 + f] = (float)cc; RT[pi * 16 + 8 + f] = (float)ss; } }
    { const f32x4* ck = (const f32x4*)A.in[6]; const f32x4* cv = (const f32x4*)A.in[7]; f32x4* ok = (f32x4*)(A.out + O_SK); f32x4* ov = (f32x4*)(A.out + O_SV);
      for (int i = gt; i < 128 * 120 * 64; i += NGT) { const int b = i / (120 * 64), rem = i - b * (120 * 64);
          ok[(size_t)b * 128 * 64 + rem] = ck[(size_t)b * 128 * 64 + 8 * 64 + rem]; ov[(size_t)b * 128 * 64 + rem] = cv[(size_t)b * 128 * 64 + 8 * 64 + rem]; } }
}

__device__ __forceinline__ const float* xs_row(const Args& A, int r, bool from_input) {
    if (from_input) return r < MP ? A.in[0] + (size_t)r * DM : A.in[1] + (size_t)(r - MP) * DM;
    return A.out + (size_t)r * DM;
}
__device__ __forceinline__ void row_load(const float* xrow, int lane, f32x4 (&v)[4], float& rstd) {
    const f32x4* xr = (const f32x4*)xrow + lane; float s = 0.f;
#pragma unroll
    for (int j = 0; j < 4; ++j) { v[j] = xr[64 * j]; s += (v[j].x * v[j].x + v[j].y * v[j].y) + (v[j].z * v[j].z + v[j].w * v[j].w); }
    rstd = 1.0f / sqrtf(wave_sum(s) * (1.0f / DM) + EPS);
}
__device__ __forceinline__ void row_mod_store(const f32x4 (&v)[4], float rstd, const float* g, const float* sh, const float* sc, bf16* orow, int lane) {
#pragma unroll
    for (int j = 0; j < 4; ++j) { const int c = 4 * lane + 256 * j;
        const f32x4 gg = *(const f32x4*)(g + c), s = *(const f32x4*)(sh + c), k = *(const f32x4*)(sc + c);
        f32x4 y = (v[j] * rstd) * gg; y = y * (k + 1.0f) + s;
        uint2 o; o.x = pk2(y[0], y[1]); o.y = pk2(y[2], y[3]); *(uint2*)(orow + c) = o; }
}
__device__ __forceinline__ void norm_phase(Frame& F, const Args& A, bool from_input, const float* g, int off_sh, int off_sc, bf16* H, const float* g2, int off_sh2, int off_sc2, bf16* H2) {
    const int gw = F.bx * NWAVES + F.wave, NGW = F.G * NWAVES;
    const float* MODS = (const float*)(A.ws + WS_MODS);
    for (int r = gw; r < MT; r += NGW) {
        f32x4 v[4]; float rstd; row_load(xs_row(A, r, from_input), F.lane, v, rstd);
        const float* mrow = MODS + (size_t)cond_row(r) * NMOD;
        row_mod_store(v, rstd, g, mrow + off_sh, mrow + off_sc, H + (size_t)r * DM, F.lane);
        if (H2) row_mod_store(v, rstd, g2, mrow + off_sh2, mrow + off_sc2, H2 + (size_t)r * DM, F.lane);
    }
}
__device__ __forceinline__ void final_norm_phase(Frame& F, const Args& A, const float* g) {
    const int gw = F.bx * NWAVES + F.wave, NGW = F.G * NWAVES;
    for (int r = gw; r < MT; r += NGW) {
        float* xrow = A.out + (size_t)r * DM; f32x4 v[4]; float rstd; row_load(xrow, F.lane, v, rstd);
#pragma unroll
        for (int j = 0; j < 4; ++j) { const int c = 4 * F.lane + 256 * j; const f32x4 gg = *(const f32x4*)(g + c); *(f32x4*)(xrow + c) = (v[j] * rstd) * gg; }
    }
}

constexpr int RNN_STG_ROW = 272;
constexpr int RNN_STG_WAVE = 24 * RNN_STG_ROW;
constexpr int RNN_LDS_CW = 0;
constexpr int RNN_LDS_RC = 2560;
constexpr int RNN_LDS_TOT = 4096;
constexpr int RNN_LDS_STG = 8192;


__device__ __forceinline__ float gelu_tanh(float x) {
    const float z2 = 1.5957691216057308f * (x + 0.044715f * x * x * x);
    return x * __builtin_amdgcn_rcpf(1.0f + __builtin_amdgcn_exp2f(-1.4426950408889634f * z2));
}

template <bool SAMPLE>
__device__ __forceinline__ void rnn_block(const Frame& F, const Args& A, int n, int q, int seq0, int tok0, const pg8::bf16x8 (&wfrag)[4][4], float (&hc)[8], int parity, bool last_chunk) {
    const int lane = F.lane, tk = lane & 15, kq = lane >> 4, w = F.wave;
    const bf16* XR = (const bf16*)(A.ws + WS_XR); const bf16* YG = (const bf16*)(A.ws + WS_YG); bf16* OG = (bf16*)(A.ws + WS_C);
    LAS unsigned char* stg = F.lds + RNN_LDS_STG + w * RNN_STG_WAVE;
    const LAS float* cw = (const LAS float*)(F.lds + RNN_LDS_CW);
    constexpr int NROW = SAMPLE ? 22 : 19;
#pragma unroll
    for (int it = 0; it < (NROW * 16 + 63) / 64; ++it) {
        const int idx = lane + 64 * it;
        if (idx < NROW * 16) {
            const int row = idx >> 4, c16 = idx & 15; v4u val = {0u, 0u, 0u, 0u};
            if (SAMPLE) {
                const int s = row >= 11 ? 1 : 0, j = row - 11 * s, b = seq0 + s;
                if (j < 3) { const float* sp = A.in[4] + ((size_t)b * 3 + j) * DM + n * 128 + c16 * 8; const f32x4 a0 = *(const f32x4*)sp, a1 = *(const f32x4*)(sp + 4);
                    val.x = pk2(a0[0], a0[1]); val.y = pk2(a0[2], a0[3]); val.z = pk2(a1[0], a1[1]); val.w = pk2(a1[2], a1[3]); }
                else val = *(const v4u*)(XR + (size_t)(MP + b * 8 + (j - 3)) * DM + n * 128 + c16 * 8);
            } else {
                const int t = tok0 - 3 + row;
                if (t >= 0) val = *(const v4u*)(XR + (size_t)(seq0 * 2048 + t) * DM + n * 128 + c16 * 8);
            }
            *(LAS v4u*)(stg + row * RNN_STG_ROW + c16 * 16) = val;
        }
    }
    const int grow = SAMPLE ? (MP + (seq0 + (tk >> 3)) * 8 + (tk & 7)) : (seq0 * 2048 + tok0 + tk);
    const int lrow = SAMPLE ? ((tk >> 3) * 11 + 3 + (tk & 7)) : (3 + tk);
    const int chg = n * 128 + q * 32 + kq * 8;
    const v4u ygv = *(const v4u*)(YG + (size_t)grow * DM + chg);
    LDS_WAIT(); asm volatile("" ::: "memory");
    pg8::bf16x8 bfrag[4]; float xcf[8];
#pragma unroll
    for (int ks = 0; ks < 4; ++ks) {
        const int kc = ks * 32 + kq * 8;
        float xc[8];
        { const f32x4 b0 = *(const LAS f32x4*)(cw + 4 * 128 + kc), b1 = *(const LAS f32x4*)(cw + 4 * 128 + kc + 4);
#pragma unroll
          for (int e = 0; e < 4; ++e) { xc[e] = b0[e]; xc[4 + e] = b1[e]; } }
#pragma unroll
        for (int d = 0; d < 4; ++d) {
            const v4u xv = *(const LAS v4u*)(stg + (lrow - d) * RNN_STG_ROW + kc * 2);
            const f32x4 w0 = *(const LAS f32x4*)(cw + (3 - d) * 128 + kc), w1 = *(const LAS f32x4*)(cw + (3 - d) * 128 + kc + 4);
            xc[0] += w0[0] * bflo(xv.x); xc[1] += w0[1] * bfhi(xv.x); xc[2] += w0[2] * bflo(xv.y); xc[3] += w0[3] * bfhi(xv.y);
            xc[4] += w1[0] * bflo(xv.z); xc[5] += w1[1] * bfhi(xv.z); xc[6] += w1[2] * bflo(xv.w); xc[7] += w1[3] * bfhi(xv.w);
        }
        v4u pk; pk.x = pk2(xc[0], xc[1]); pk.y = pk2(xc[2], xc[3]); pk.z = pk2(xc[4], xc[5]); pk.w = pk2(xc[6], xc[7]);
        bfrag[ks] = __builtin_bit_cast(pg8::bf16x8, pk);
        if (ks == q) {
#pragma unroll
            for (int e = 0; e < 8; ++e) xcf[e] = xc[e];
        }
        asm volatile("" ::: "memory");
    }
    f32x4 acc[4];
#pragma unroll
    for (int mt = 0; mt < 4; ++mt) { acc[mt] = (f32x4){0.f, 0.f, 0.f, 0.f};
#pragma unroll
        for (int ks = 0; ks < 4; ++ks) acc[mt] = __builtin_amdgcn_mfma_f32_16x16x32_bf16(wfrag[mt][ks], bfrag[ks], acc[mt], 0, 0, 0); }
    float av[8], uv[8];
    const LAS float* rcp = (const LAS float*)(F.lds + RNN_LDS_RC) + kq * 8;
    float gbr[8], gbi[8], c8[8];
    { const f32x4 a0 = *(const LAS f32x4*)rcp, a1 = *(const LAS f32x4*)(rcp + 4), b0 = *(const LAS f32x4*)(rcp + 32), b1 = *(const LAS f32x4*)(rcp + 36), c0 = *(const LAS f32x4*)(rcp + 64), c1 = *(const LAS f32x4*)(rcp + 68);
#pragma unroll
      for (int e = 0; e < 4; ++e) { gbr[e] = a0[e]; gbr[4 + e] = a1[e]; gbi[e] = b0[e]; gbi[4 + e] = b1[e]; c8[e] = c0[e]; c8[4 + e] = c1[e]; } }
#pragma unroll
    for (int cj = 0; cj < 8; ++cj) {
        const float gr = acc[cj >> 2][cj & 3] + gbr[cj], gi = acc[2 + (cj >> 2)][cj & 3] + gbi[cj];
        const float r = fast_sig(gr), ig = fast_sig(gi);
        const float la = r * c8[cj];
        const float a = __expf(la);
        const float z = 2.0f * la;
        const float m = (z > -0.25f) ? (-z * (1.0f + z * (0.5f + z * (0.16666667f + z * (0.041666668f + z * (0.0083333338f + z * 0.0013888889f)))))) : (1.0f - __expf(z));
        av[cj] = a; uv[cj] = sqrtf(m) * (ig * xcf[cj]);
    }
    constexpr int SEG = SAMPLE ? 8 : 16;
#pragma unroll
    for (int d = 1; d < SEG; d <<= 1) {
        const bool ok = (tk & (SEG - 1)) >= d;
#pragma unroll
        for (int cj = 0; cj < 8; ++cj) {
            const float ap = __shfl_up(av[cj], d, 16), up = __shfl_up(uv[cj], d, 16);
            if (ok) { uv[cj] = av[cj] * up + uv[cj]; av[cj] = av[cj] * ap; }
        }
    }
    float hin[8];
    if (SAMPLE) {
        const float* hp = A.in[5] + (size_t)(seq0 + (tk >> 3)) * DM + chg; const f32x4 h0 = *(const f32x4*)hp, h1 = *(const f32x4*)(hp + 4);
#pragma unroll
        for (int e = 0; e < 4; ++e) { hin[e] = h0[e]; hin[4 + e] = h1[e]; }
    } else {
        LAS float* tot = (LAS float*)(F.lds + RNN_LDS_TOT) + parity * 512;
        if (tk == 15) {
#pragma unroll
            for (int cj = 0; cj < 8; ++cj) { tot[w * 64 + kq * 8 + cj] = av[cj]; tot[w * 64 + 32 + kq * 8 + cj] = uv[cj]; }
        }
        __syncthreads();
#pragma unroll
        for (int cj = 0; cj < 8; ++cj) hin[cj] = hc[cj];
#pragma unroll
        for (int ww = 0; ww < 8; ++ww) {
            const f32x4 a0 = *(const LAS f32x4*)(tot + ww * 64 + kq * 8), a1 = *(const LAS f32x4*)(tot + ww * 64 + kq * 8 + 4);
            const f32x4 u0 = *(const LAS f32x4*)(tot + ww * 64 + 32 + kq * 8), u1 = *(const LAS f32x4*)(tot + ww * 64 + 32 + kq * 8 + 4);
#pragma unroll
            for (int e = 0; e < 4; ++e) {
                if (ww == w) { hin[e] = hc[e]; hin[4 + e] = hc[4 + e]; }
                hc[e] = a0[e] * hc[e] + u0[e]; hc[4 + e] = a1[e] * hc[4 + e] + u1[e];
            }
            if (ww & 1) asm volatile("" ::: "memory");
        }
    }
    float hv[8], ov[8];
    const float yg[8] = {bflo(ygv.x), bfhi(ygv.x), bflo(ygv.y), bfhi(ygv.y), bflo(ygv.z), bfhi(ygv.z), bflo(ygv.w), bfhi(ygv.w)};
#pragma unroll
    for (int cj = 0; cj < 8; ++cj) { hv[cj] = av[cj] * hin[cj] + uv[cj]; ov[cj] = hv[cj] * gelu_tanh(yg[cj]); }
    v4u o; o.x = pk2(ov[0], ov[1]); o.y = pk2(ov[2], ov[3]); o.z = pk2(ov[4], ov[5]); o.w = pk2(ov[6], ov[7]);
    *(v4u*)(OG + (size_t)grow * DM + chg) = o;
    if (SAMPLE) {
        if ((tk & 7) == 7) { float* hp = A.out + O_SH + (size_t)(seq0 + (tk >> 3)) * DM + chg;
            *(f32x4*)hp = (f32x4){hv[0], hv[1], hv[2], hv[3]}; *(f32x4*)(hp + 4) = (f32x4){hv[4], hv[5], hv[6], hv[7]}; }
    } else if (last_chunk && w == 7 && tk == 15) { float* hp = A.out + O_PH + (size_t)seq0 * DM + chg;
        *(f32x4*)hp = (f32x4){hv[0], hv[1], hv[2], hv[3]}; *(f32x4*)(hp + 4) = (f32x4){hv[4], hv[5], hv[6], hv[7]}; }
}

__device__ __forceinline__ void rnn_load_group(const Frame& F, const Args& A, int n, int q, pg8::bf16x8 (&wfrag)[4][4]) {
    const int lane = F.lane;
    const v4u* wf = (const v4u*)(A.ws + WS_WGF) + (size_t)(n * 4 + q) * 1024 + lane;
#pragma unroll
    for (int mt = 0; mt < 4; ++mt)
#pragma unroll
        for (int ks = 0; ks < 4; ++ks) wfrag[mt][ks] = __builtin_bit_cast(pg8::bf16x8, wf[(mt * 4 + ks) * 64]);
    if (F.tid < 32) { LAS float* rcw = (LAS float*)(F.lds + RNN_LDS_RC); const int c = q * 32 + F.tid;
        rcw[F.tid] = A.in[15][n * 256 + c]; rcw[32 + F.tid] = A.in[15][n * 256 + 128 + c];
        const float lam = A.in[16][n * 128 + c];
        rcw[64 + F.tid] = 8.0f * (fminf(lam, 0.f) - log1pf(__expf(-fabsf(lam)))); }
}
__device__ __forceinline__ void rnn_load_convw(const Frame& F, const Args& A, int n) {
    LAS float* cw = (LAS float*)(F.lds + RNN_LDS_CW);
    for (int i = F.tid; i < 5 * 128; i += NWAVES * 64) { const int k = i >> 7, c = i & 127; cw[i] = (k < 4) ? A.in[12][k * DM + n * 128 + c] : A.in[13][n * 128 + c]; }
}

__device__ __forceinline__ void rnn_phase(Frame& F, const Args& A) {
    const int gt = F.bx * (NWAVES * 64) + F.tid, NGT = F.G * NWAVES * 64;
    const bf16* XR = (const bf16*)(A.ws + WS_XR);
    for (int i = gt; i < (8 + 128) * 3 * 256; i += NGT) { const int c4 = (i & 255) * 4, rj = i >> 8, b = rj / 3, j = rj - 3 * b;
        const size_t srow = b < 8 ? ((size_t)b * 2048 + 2045 + j) : ((size_t)MP + (b - 8) * 8 + 5 + j);
        const uint2 v = *(const uint2*)(XR + srow * DM + c4);
        float* dst = b < 8 ? (A.out + O_PCONV + ((size_t)b * 3 + j) * DM + c4) : (A.out + O_SCONV + ((size_t)(b - 8) * 3 + j) * DM + c4);
        *(f32x4*)dst = (f32x4){bflo(v.x), bfhi(v.x), bflo(v.y), bfhi(v.y)}; }
    pg8::bf16x8 wfrag[4][4];
    for (int u = F.bx; u < 256; u += F.G) {
        const int b = u >> 5, grp = u & 31, n = grp >> 2, q = grp & 3;
        __syncthreads();
        rnn_load_convw(F, A, n); rnn_load_group(F, A, n, q, wfrag);
        __syncthreads();
        float hc[8];
#pragma unroll
        for (int e = 0; e < 8; ++e) hc[e] = 0.f;
        for (int ch = 0; ch < 16; ++ch) rnn_block<false>(F, A, n, q, b, ch * 128 + F.wave * 16, wfrag, hc, ch & 1, ch == 15);
    }
    for (int u = F.bx; u < 256; u += F.G) {
        const int grp = u & 31, n = grp >> 2, q = grp & 3, sb = (u >> 5) * 8 + F.wave;
        __syncthreads();
        rnn_load_convw(F, A, n); rnn_load_group(F, A, n, q, wfrag);
        __syncthreads();
        float hc[8];
        rnn_block<true>(F, A, n, q, 2 * sb, 0, wfrag, hc, 0, false);
    }
    __syncthreads();
}

constexpr int AT_KROW = 144;
constexpr int AT_VROW = 400;
constexpr int AT_LDS_K = 0, AT_LDS_V = 192 * AT_KROW;
typedef float f32x16 __attribute__((ext_vector_type(16)));
typedef short s16x4 __attribute__((ext_vector_type(4)));

__device__ __forceinline__ int crow16(int r, int hi) { return (r & 3) + 8 * (r >> 2) + 4 * hi; }

template <bool SAMPLE>
__device__ __forceinline__ void attn_unit(const Frame& F, const Args& A, int b, int kvh, int tb) {
    constexpr int NKT = SAMPLE ? 5 : 6, NKEY = NKT * 32;
    const bf16* QB = (const bf16*)(A.ws + WS_Q); const bf16* KB = (const bf16*)(A.ws + WS_K); const bf16* VB = (const bf16*)(A.ws + WS_V); bf16* AO = (bf16*)(A.ws + WS_C);
    LAS unsigned char* Ks = F.lds + AT_LDS_K; LAS unsigned char* Vs = F.lds + AT_LDS_V;
    const int t0 = tb * 64, kbase = t0 - 128;
    for (int idx = F.tid; idx < NKEY * 8; idx += NWAVES * 64) {
        const int key = idx >> 3, c8 = idx & 7; v4u kv = {0u, 0u, 0u, 0u}, vv = {0u, 0u, 0u, 0u};
        if (SAMPLE) {
            if (key < 128) { const size_t off = (((size_t)b * 128 + key) * 4 + kvh) * 64 + c8 * 8; const float* kp = A.in[6] + off; const float* vp = A.in[7] + off;
                const f32x4 k0 = *(const f32x4*)kp, k1 = *(const f32x4*)(kp + 4), v0 = *(const f32x4*)vp, v1 = *(const f32x4*)(vp + 4);
                kv.x = pk2(k0[0], k0[1]); kv.y = pk2(k0[2], k0[3]); kv.z = pk2(k1[0], k1[1]); kv.w = pk2(k1[2], k1[3]);
                vv.x = pk2(v0[0], v0[1]); vv.y = pk2(v0[2], v0[3]); vv.z = pk2(v1[0], v1[1]); vv.w = pk2(v1[2], v1[3]); }
            else if (key < 136) { const size_t off = (size_t)(MP + b * 8 + (key - 128)) * 256 + kvh * 64 + c8 * 8; kv = *(const v4u*)(KB + off); vv = *(const v4u*)(VB + off); }
        } else {
            const int pos = kbase + key;
            if (pos >= 0) { const size_t off = (size_t)(b * 2048 + pos) * 256 + kvh * 64 + c8 * 8; kv = *(const v4u*)(KB + off); vv = *(const v4u*)(VB + off); }
        }
        *(LAS v4u*)(Ks + key * AT_KROW + c8 * 16) = kv;
        LAS unsigned short* vt = (LAS unsigned short*)(Vs + (c8 * 8) * AT_VROW + key * 2);
        vt[0 * (AT_VROW / 2)] = (unsigned short)(vv.x & 0xffffu); vt[1 * (AT_VROW / 2)] = (unsigned short)(vv.x >> 16);
        vt[2 * (AT_VROW / 2)] = (unsigned short)(vv.y & 0xffffu); vt[3 * (AT_VROW / 2)] = (unsigned short)(vv.y >> 16);
        vt[4 * (AT_VROW / 2)] = (unsigned short)(vv.z & 0xffffu); vt[5 * (AT_VROW / 2)] = (unsigned short)(vv.z >> 16);
        vt[6 * (AT_VROW / 2)] = (unsigned short)(vv.w & 0xffffu); vt[7 * (AT_VROW / 2)] = (unsigned short)(vv.w >> 16);
    }
    __syncthreads();
    if (!SAMPLE || F.wave == 0) {
        const int lane = F.lane, ql = lane & 31, hi = lane >> 5, w = F.wave;
        int grow, head, lo, hik;
        if (SAMPLE) { const int t = ql & 7, g = ql >> 3; grow = MP + b * 8 + t; head = kvh * 4 + g; lo = t; hik = 128 + t; }
        else { const int tl = 32 * (w >> 2) + ql; grow = b * 2048 + t0 + tl; head = kvh * 4 + (w & 3); hik = 128 + tl; lo = tl; if (lo < -kbase) lo = -kbase; }
        pg8::bf16x8 qf[4];
#pragma unroll
        for (int ks = 0; ks < 4; ++ks) qf[ks] = *(const pg8::bf16x8*)(QB + (size_t)grow * DM + head * 64 + ks * 16 + hi * 8);
        const float sink = A.in[23][head] * 1.4426950408889634f;
        f32x16 p[NKT];
#pragma unroll
        for (int kt = 0; kt < NKT; ++kt) {
            p[kt] = (f32x16){0.f, 0.f, 0.f, 0.f, 0.f, 0.f, 0.f, 0.f, 0.f, 0.f, 0.f, 0.f, 0.f, 0.f, 0.f, 0.f};
#pragma unroll
            for (int ks = 0; ks < 4; ++ks) { const pg8::bf16x8 kf = *(const LAS pg8::bf16x8*)(Ks + (kt * 32 + ql) * AT_KROW + ks * 32 + hi * 16);
                p[kt] = __builtin_amdgcn_mfma_f32_32x32x16_bf16(kf, qf[ks], p[kt], 0, 0, 0); }
        }
        float mx = sink;
#pragma unroll
        for (int kt = 0; kt < NKT; ++kt)
#pragma unroll
            for (int r = 0; r < 16; ++r) { const int i = kt * 32 + crow16(r, hi); const bool ok = (i >= lo) && (i <= hik); const float s = ok ? p[kt][r] : -1e30f; p[kt][r] = s; mx = fmaxf(mx, s); }
        mx = fmaxf(mx, __shfl_xor(mx, 32));
        float l = 0.f;
#pragma unroll
        for (int kt = 0; kt < NKT; ++kt)
#pragma unroll
            for (int r = 0; r < 16; ++r) { const float e = __builtin_amdgcn_exp2f(p[kt][r] - mx); p[kt][r] = e; l += e; }
        l += __shfl_xor(l, 32);
        l += __builtin_amdgcn_exp2f(sink - mx);
        const float rl = 1.0f / l;
        f32x16 o[2];
#pragma unroll
        for (int dt = 0; dt < 2; ++dt) o[dt] = (f32x16){0.f, 0.f, 0.f, 0.f, 0.f, 0.f, 0.f, 0.f, 0.f, 0.f, 0.f, 0.f, 0.f, 0.f, 0.f, 0.f};
#pragma unroll
        for (int kt = 0; kt < NKT; ++kt)
#pragma unroll
            for (int s = 0; s < 2; ++s) {
                v4u pw; pw.x = pk2(p[kt][8 * s + 0], p[kt][8 * s + 1]); pw.y = pk2(p[kt][8 * s + 2], p[kt][8 * s + 3]); pw.z = pk2(p[kt][8 * s + 4], p[kt][8 * s + 5]); pw.w = pk2(p[kt][8 * s + 6], p[kt][8 * s + 7]);
                const pg8::bf16x8 pb = __builtin_bit_cast(pg8::bf16x8, pw);
#pragma unroll
                for (int dt = 0; dt < 2; ++dt) {
                    const LAS unsigned char* vp = Vs + (dt * 32 + ql) * AT_VROW + (kt * 32 + s * 16 + hi * 4) * 2;
                    const s16x4 va = *(const LAS s16x4*)vp, vb = *(const LAS s16x4*)(vp + 16);
                    const pg8::bf16x8 vf = {va[0], va[1], va[2], va[3], vb[0], vb[1], vb[2], vb[3]};
                    o[dt] = __builtin_amdgcn_mfma_f32_32x32x16_bf16(vf, pb, o[dt], 0, 0, 0);
                }
            }
        bf16* orow = AO + (size_t)grow * DM + head * 64;
#pragma unroll
        for (int dt = 0; dt < 2; ++dt)
#pragma unroll
            for (int g = 0; g < 4; ++g) { uint2 w2; w2.x = pk2(o[dt][4 * g + 0] * rl, o[dt][4 * g + 1] * rl); w2.y = pk2(o[dt][4 * g + 2] * rl, o[dt][4 * g + 3] * rl);
                *(uint2*)(orow + dt * 32 + g * 8 + hi * 4) = w2; }
    }
    __syncthreads();
}

__device__ __forceinline__ void attn_phase(Frame& F, const Args& A) {
    for (int u = F.bx; u < 1024; u += F.G) attn_unit<false>(F, A, u >> 7, (u >> 5) & 3, u & 31);
    for (int u = F.bx; u < 512; u += F.G) attn_unit<true>(F, A, u >> 2, u & 3, 0);
}

__global__ void __launch_bounds__(NWAVES * 64, 2) trunk_fwd(Args A) {
    extern __shared__ __attribute__((aligned(16))) unsigned char lds[];
    Frame F;
    F.lds = (LAS unsigned char*)lds;
    F.tid = threadIdx.x; F.lane = F.tid & 63; F.wave = __builtin_amdgcn_readfirstlane(F.tid >> 6);
    F.G = gridDim.x; F.bx = blockIdx.x;
    unsigned char* ws = A.ws;
    gu32* ctl = (gu32*)(ws + WS_CTL);
    for (int u = F.tid; u < (LDS_BYTES - LDSCTL_OFF) / 4; u += NWAVES * 64) ((LAS unsigned*)(F.lds + LDSCTL_OFF))[u] = 0u;
    __syncthreads();
    const int lo = A.ph_lo, hi = A.ph_hi;
    const bool multi = (hi - lo) > 1;
    XcdBarrier bar; bar.bar = (unsigned*)(ctl + CW_BAR); bar.x = 0; bar.st = nullptr;
    if (multi) bar = xcd_barrier_post((unsigned*)(ctl + CW_BAR), (volatile LAS unsigned*)(F.lds + MISC_OFF) + 8);
#ifndef PH_MASK
#define PH_MASK 0
#endif
#define IN(k) (lo <= (k) && (k) < hi && !((PH_MASK >> (k)) & 1))
#define SEAM(k) do { if (IN(k) && IN((k) + 1)) xcd_barrier(bar); } while (0)
    PG8_LAS unsigned char* ring = (PG8_LAS unsigned char*)(F.lds + RING_OFF);
    const float* MODS = (const float*)(ws + WS_MODS);
    bf16* H = (bf16*)(ws + WS_C); bf16* HK = (bf16*)(ws + WS_HK);
    constexpr int NOSPLIT = 1 << 30;

    if (IN(0)) { p0_prologue(F, A); SEAM(0); }
    if (IN(1)) {
        pg8::Gemm g{(const pg8::bf16_t*)(ws + WS_SC), (const pg8::bf16_t*)(ws + WS_SC), NOSPLIT, (const pg8::bf16_t*)(ws + WS_WADA), 256, NMOD, 1024};
        pg8::StaticOrder S; S.init(256, NMOD, F.G, F.bx);
        pg8::EpiAda E{(float*)(ws + WS_MODS), A.in[9], A.in[19]};
        pg8::gemm_phase<pg8::EpiAda, pg8::StaticOrder, true, true>(ring, g, S, E);
        SEAM(1);
    }
    if (IN(2)) { norm_phase(F, A, true, A.in[10], 0, 1024, H, nullptr, 0, 0, nullptr); SEAM(2); }
    if (IN(3)) {
        pg8::Gemm g{(const pg8::bf16_t*)H, (const pg8::bf16_t*)H, NOSPLIT, (const pg8::bf16_t*)(ws + WS_WIN), MT, 2048, 1024};
        pg8::StaticOrder S; S.init(MT, 2048, F.G, F.bx);
        pg8::EpiBf16x2 E{(pg8::bf16_t*)(ws + WS_XR), (pg8::bf16_t*)(ws + WS_YG)};
        pg8::gemm_phase<pg8::EpiBf16x2, pg8::StaticOrder, true, true>(ring, g, S, E);
        SEAM(3);
    }
    if (IN(4)) { rnn_phase(F, A); SEAM(4); }
    if (IN(5)) {
        pg8::Gemm g{(const pg8::bf16_t*)H, (const pg8::bf16_t*)H, NOSPLIT, (const pg8::bf16_t*)(ws + WS_WOUT), MT, 1024, 1024};
        pg8::StaticOrder S; S.init(MT, 1024, F.G, F.bx);
        pg8::EpiResGate E{A.in[0], A.in[1], A.out, MODS, 2048};
        pg8::gemm_phase<pg8::EpiResGate, pg8::StaticOrder, true, true>(ring, g, S, E);
        SEAM(5);
    }
    if (IN(6)) { norm_phase(F, A, false, A.in[10] + 1024, 3072, 4096, H, nullptr, 0, 0, nullptr); SEAM(6); }
    if (IN(7)) {
        pg8::Gemm g{(const pg8::bf16_t*)H, (const pg8::bf16_t*)H, NOSPLIT, (const pg8::bf16_t*)(ws + WS_WFI), MT, 2 * FF, 1024};
        pg8::StaticOrder S; S.init(MT, 2 * FF, F.G, F.bx);
        pg8::EpiSwiGLU E{(pg8::bf16_t*)(ws + WS_ACT)};
        pg8::gemm_phase<pg8::EpiSwiGLU, pg8::StaticOrder, true, true>(ring, g, S, E);
        SEAM(7);
    }
    if (IN(8)) {
        pg8::Gemm g{(const pg8::bf16_t*)(ws + WS_ACT), (const pg8::bf16_t*)(ws + WS_ACT), NOSPLIT, (const pg8::bf16_t*)(ws + WS_WFO), MT, 1024, FF};
        pg8::StaticOrder S; S.init(MT, 1024, F.G, F.bx);
        pg8::EpiResGate E{A.out, A.out + (size_t)MP * DM, A.out, MODS, 5120};
        pg8::gemm_phase<pg8::EpiResGate, pg8::StaticOrder, true, true>(ring, g, S, E);
        SEAM(8);
    }
    if (IN(9)) { norm_phase(F, A, false, A.in[10] + 2048, 6144, 6144 + 1024, H, A.in[20], 12288, 13312, HK); SEAM(9); }
    if (IN(10)) {
        pg8::Gemm g{(const pg8::bf16_t*)HK, (const pg8::bf16_t*)H, 2, (const pg8::bf16_t*)(ws + WS_WKVQ), MT, 1536, 1024};
        pg8::StaticOrder S; S.init(MT, 1536, F.G, F.bx);
        pg8::EpiKVQ E{(pg8::bf16_t*)(ws + WS_K), (pg8::bf16_t*)(ws + WS_V), (pg8::bf16_t*)(ws + WS_Q), (const float*)(ws + WS_ROPE), A.out};
        pg8::gemm_phase<pg8::EpiKVQ, pg8::StaticOrder, true, true>(ring, g, S, E);
        SEAM(10);
    }
    if (IN(11)) { attn_phase(F, A); SEAM(11); }
    if (IN(12)) {
        pg8::Gemm g{(const pg8::bf16_t*)H, (const pg8::bf16_t*)H, NOSPLIT, (const pg8::bf16_t*)(ws + WS_WO), MT, 1024, 1024};
        pg8::StaticOrder S; S.init(MT, 1024, F.G, F.bx);
        pg8::EpiResGate E{A.out, A.out + (size_t)MP * DM, A.out, MODS, 6144 + 2048};
        pg8::gemm_phase<pg8::EpiResGate, pg8::StaticOrder, true, true>(ring, g, S, E);
        SEAM(12);
    }
    if (IN(13)) { norm_phase(F, A, false, A.in[10] + 3072, 6144 + 3072, 6144 + 4096, H, nullptr, 0, 0, nullptr); SEAM(13); }
    if (IN(14)) {
        pg8::Gemm g{(const pg8::bf16_t*)H, (const pg8::bf16_t*)H, NOSPLIT, (const pg8::bf16_t*)(ws + WS_WFI + WFI_BYTES), MT, 2 * FF, 1024};
        pg8::StaticOrder S; S.init(MT, 2 * FF, F.G, F.bx);
        pg8::EpiSwiGLU E{(pg8::bf16_t*)(ws + WS_ACT)};
        pg8::gemm_phase<pg8::EpiSwiGLU, pg8::StaticOrder, true, true>(ring, g, S, E);
        SEAM(14);
    }
    if (IN(15)) {
        pg8::Gemm g{(const pg8::bf16_t*)(ws + WS_ACT), (const pg8::bf16_t*)(ws + WS_ACT), NOSPLIT, (const pg8::bf16_t*)(ws + WS_WFO + WFO_BYTES), MT, 1024, FF};
        pg8::StaticOrder S; S.init(MT, 1024, F.G, F.bx);
        pg8::EpiResGate E{A.out, A.out + (size_t)MP * DM, A.out, MODS, 6144 + 5120};
        pg8::gemm_phase<pg8::EpiResGate, pg8::StaticOrder, true, true>(ring, g, S, E);
        SEAM(15);
    }
    if (IN(16)) { final_norm_phase(F, A, A.in[27]); }
#undef IN
#undef SEAM
}

#ifndef N_LAUNCH_MODE
#define N_LAUNCH_MODE 1
#endif
extern "C" void kernel_launch(void* const* d_in, const int* in_sizes, int n_in, void* d_out, int out_size, void* d_ws, size_t ws_size, hipStream_t stream) {
    static int grid = 0;
    if (grid == 0) {
        if (n_in != 28 || out_size != (int)O_END || ws_size < WS_END) { fprintf(stderr, "kernel_launch: unexpected problem shape (n_in %d, out %d, ws %zu)\n", n_in, out_size, ws_size); grid = -1; return; }
        int dev = 0, cus = 0, per_cu = 0;
        if (hipGetDevice(&dev) != hipSuccess || hipDeviceGetAttribute(&cus, hipDeviceAttributeMultiprocessorCount, dev) != hipSuccess) { grid = -1; return; }
        if (hipFuncSetAttribute((const void*)trunk_fwd, hipFuncAttributeMaxDynamicSharedMemorySize, LDS_BYTES) != hipSuccess) { fprintf(stderr, "kernel_launch: hipFuncSetAttribute failed\n"); grid = -1; return; }
        if (hipOccupancyMaxActiveBlocksPerMultiprocessor(&per_cu, (const void*)trunk_fwd, NWAVES * 64, LDS_BYTES) != hipSuccess || per_cu < 1) { fprintf(stderr, "kernel_launch: occupancy query says %d blocks per CU\n", per_cu); per_cu = 1; }
        (void)hipGetLastError();
        grid = cus;
    }
    if (grid < 0) return;
    (void)hipMemsetAsync((char*)d_ws + WS_CTL, 0, CTL_ZERO_BYTES, stream);
    Args a{};
    for (int i = 0; i < 28; ++i) a.in[i] = (const float*)d_in[i];
    a.out = (float*)d_out; a.ws = (unsigned char*)d_ws;
    for (int f = 0; f < 8; ++f) a.inv[f] = (float)pow(500000.0, -(double)(2 * f) / 16.0);
#if N_LAUNCH_MODE == 1
    a.ph_lo = 0; a.ph_hi = NPHASE;
    hipLaunchKernelGGL(trunk_fwd, dim3(grid), dim3(NWAVES * 64), LDS_BYTES, stream, a);
#else
    for (int p = 0; p < NPHASE; ++p) { a.ph_lo = p; a.ph_hi = p + 1; hipLaunchKernelGGL(trunk_fwd, dim3(grid), dim3(NWAVES * 64), LDS_BYTES, stream, a); }
#endif
}
```

```cpp
#include <hip/hip_runtime.h>
#include <cstdio>
#include <cstdint>
#include <cmath>

constexpr int DM = 1024;
constexpr int MP = 16384, MS = 1024, MT = MP + MS;
constexpr int NCOND = 136;
constexpr int FF = 2816, NMOD = 14336;
constexpr float EPS = 1e-6f;
constexpr float QSCALE = 0.125f * 1.4426950408889634f;
constexpr size_t O_Y = 0, O_PCONV = 17825792, O_PH = 17850368, O_PK = 17858560, O_PV = 18120704, O_SCONV = 18382848, O_SH = 18776064, O_SK = 18907136, O_SV = 23101440, O_END = 27295744;
__device__ __forceinline__ int cond_row(int r) { return r < MP ? (r >> 11) : 8 + ((r - MP) >> 3); }

namespace pg8 {
#define PG8_LAS __attribute__((address_space(3)))
typedef unsigned short bf16_t;
typedef short bf16x8 __attribute__((ext_vector_type(8)));
typedef float f32x4 __attribute__((ext_vector_type(4)));
typedef unsigned u32x4 __attribute__((ext_vector_type(4)));
constexpr int BM = 256, BK = 64, HALF = 128, HTB = HALF * BK * 2  , STAGE_BYTES = 8 * HTB, NXCD = 8, WGM = 8;

__host__ __device__ __forceinline__ int lds_byte(int r, int c) { const int st = (r >> 4) * 2 + (c >> 5), rr = r & 15, cc = c & 31, ob = rr * 64 + cc * 2; return st * 1024 + (ob ^ (((ob >> 9) & 1) << 5)); }
__host__ __device__ __forceinline__ void stage_rc(int b, int& R, int& C) { const int st = b / 1024, sb = b % 1024, swz = sb ^ (((sb >> 9) & 1) << 5); R = (st >> 1) * 16 + swz / 64; C = (st & 1) * 32 + (swz % 64) / 2; }
__host__ __device__ __forceinline__ int perm32(int rho) { const int n = rho >> 4, i = rho & 15; return 8 * (i >> 2) + 4 * n + (i & 3); }

struct Unit { int pm, pn, k0, nt, at; };
struct Gemm { const bf16_t* A; const bf16_t* A2; int pn_split; const bf16_t* Bt; int M, N, K; };

struct StaticOrder {
    int nM, nN, nwg, G, c;
    int ntk; __host__ __device__ void init(int M, int N, int G_, int c_, int K) { nM = M / BM; nN = N / BM; nwg = nM * nN; G = G_; c = c_; ntk = K / BK; }
    __host__ __device__ __forceinline__ bool next(int i, Unit& u) const { const long L = (long)i * G + c; const bool ok = L < nwg; map(ok ? (int)L : 0, u); return ok; }
    __host__ __device__ __forceinline__ void map(int wgid, Unit& u) const { { const int q = nwg / NXCD, r = nwg % NXCD, xcd = wgid % NXCD, off = wgid / NXCD; wgid = (xcd < r ? xcd * (q + 1) : r * (q + 1) + (xcd - r) * q) + off; }
        const int nig = WGM * nN, gid = wgid / nig, fm = gid * WGM, gsz = (nM - fm) < WGM ? (nM - fm) : WGM;
        u.pm = fm + ((wgid % nig) % gsz); u.pn = (wgid % nig) / gsz; u.k0 = 0; u.nt = ntk; u.at = 0;
    }
    __device__ __forceinline__ void a_ready(const Unit&) const {}
    __device__ __forceinline__ void done(const Unit&) const {}
};
struct SplitOrder {
    StaticOrder full; int n_full, nN, nMp, nsplit, ntk, e, nbig, G, c, n_pieces;
    __host__ __device__ __forceinline__ void init(int Mp, int Ms, int N, int G_, int c_, int K, int nsplit_) {
        full.init(Mp, N, G_, c_, K); n_full = full.nwg; nN = N / BM; nMp = Mp / BM; nsplit = nsplit_; ntk = K / BK; G = G_; c = c_;
        e = (ntk / nsplit) & ~1; nbig = (ntk - e * nsplit) / 2;
        n_pieces = (Ms / BM) * nN * nsplit;
    }
    __host__ __device__ __forceinline__ bool next(int i, Unit& u) const {
        const long L = (long)i * G + c;
        const bool isfull = L < n_full;
        Unit f; full.map(isfull ? (int)L : 0, f);
        const int p = isfull ? 0 : (int)(L - n_full);
        const int su = p / nsplit, part = p - su * nsplit, nsmall = nsplit - nbig;
        const bool small = part < nsmall;
        const int pk0 = small ? part * e : nsmall * e + (part - nsmall) * (e + 2), pnt = small ? e : e + 2;
        u.pm = isfull ? f.pm : nMp + su / nN; u.pn = isfull ? f.pn : su % nN; u.k0 = isfull ? 0 : pk0; u.nt = isfull ? ntk : pnt; u.at = isfull ? 0 : 1 + part;
        return isfull || p < n_pieces;
    }
    __device__ __forceinline__ void a_ready(const Unit&) const {}
    __device__ __forceinline__ void done(const Unit&) const {}
};

__device__ __forceinline__ unsigned cvt_pk_bf16(float lo, float hi) { unsigned r; asm volatile("v_cvt_pk_bf16_f32 %0, %1, %2" : "=v"(r) : "v"(lo), "v"(hi)); return r; }
typedef float f32x2 __attribute__((ext_vector_type(2)));

typedef unsigned u32x2 __attribute__((ext_vector_type(2)));
__device__ __forceinline__ float fast_sigmoid(float x) { return __builtin_amdgcn_rcpf(1.0f + __builtin_amdgcn_exp2f(-1.4426950408889634f * x)); }

struct EpiAda {
    static constexpr bool PERM = false, AFTER_DRAIN = false;
    float* C; const float* b0; const float* b1;
    __device__ __forceinline__ void operator()(const f32x4 (&acc)[2][2][4][2], const Unit& u, int wr, int wc, int fr, int fq) const {
        const int row0 = u.pm * BM + wr * 64 + fr, col0 = u.pn * BM + wc * 32 + 4 * fq;
        const float* bias = (u.pn < 48) ? (b0 + col0) : (b1 + (col0 - 12288));
        f32x4 bv[2][2];
#pragma unroll
        for (int bj = 0; bj < 2; ++bj)
#pragma unroll
            for (int n = 0; n < 2; ++n) bv[bj][n] = *(const f32x4*)(bias + bj * HALF + n * 16);
#pragma unroll
        for (int ai = 0; ai < 2; ++ai)
#pragma unroll
            for (int m = 0; m < 4; ++m) { float* rowp = C + (size_t)(row0 + ai * HALF + m * 16) * NMOD + col0;
#pragma unroll
                for (int bj = 0; bj < 2; ++bj)
#pragma unroll
                    for (int n = 0; n < 2; ++n) *(f32x4*)(rowp + bj * HALF + n * 16) = acc[ai][bj][m][n] + bv[bj][n]; }
    }
};

struct EpiBf16x2 {
    static constexpr bool PERM = true, AFTER_DRAIN = false;
    bf16_t* O0; bf16_t* O1;
    __device__ __forceinline__ void operator()(const f32x4 (&acc)[2][2][4][2], const Unit& u, int wr, int wc, int fr, int fq) const {
        const int row0 = u.pm * BM + wr * 64 + fr; int colt = u.pn * BM; bf16_t* base = O0;
        if (colt >= DM) { base = O1; colt -= DM; }
        const int col0 = colt + wc * 32 + 8 * fq;
#pragma unroll
        for (int ai = 0; ai < 2; ++ai)
#pragma unroll
            for (int m = 0; m < 4; ++m) { bf16_t* rowp = base + (size_t)(row0 + ai * HALF + m * 16) * DM + col0;
#pragma unroll
                for (int bj = 0; bj < 2; ++bj) { const f32x4 v0 = acc[ai][bj][m][0], v1 = acc[ai][bj][m][1];
                    u32x4 w; w.x = cvt_pk_bf16(v0[0], v0[1]); w.y = cvt_pk_bf16(v0[2], v0[3]); w.z = cvt_pk_bf16(v1[0], v1[1]); w.w = cvt_pk_bf16(v1[2], v1[3]);
                    *(u32x4*)(rowp + bj * HALF) = w; } }
    }
};

struct EpiResGate {
    static constexpr bool PERM = false, AFTER_DRAIN = false;
    const float* base_p; const float* base_s; float* out; const float* mods; int goff; float* slab; int dry;
    __device__ __forceinline__ void operator()(const f32x4 (&acc)[2][2][4][2], const Unit& u, int wr, int wc, int fr, int fq) const {
        const int col0 = u.pn * BM + wc * 32 + 4 * fq;
        if (dry) { if (acc[0][0][0][0][0] == 1.2345e-30f) out[0] = 0.f; return; }
#pragma unroll
        for (int ai = 0; ai < 2; ++ai)
#pragma unroll
            for (int m = 0; m < 4; ++m) {
                const int r = u.pm * BM + ai * HALF + wr * 64 + m * 16 + fr;
                const float* bp = (r < MP) ? (base_p + (size_t)r * DM) : (base_s + (size_t)(r - MP) * DM);
                const float* gp = mods + (size_t)cond_row(r) * NMOD + goff;
                float* op = out + (size_t)r * DM;
                if (u.at) {
                    float* sp = slab + ((size_t)(u.at - 1) * MS + (r - MP)) * DM;
#pragma unroll
                    for (int bj = 0; bj < 2; ++bj)
#pragma unroll
                        for (int n = 0; n < 2; ++n) { const int c = col0 + bj * HALF + n * 16;
                            const f32x4 g = *(const f32x4*)(gp + c); *(f32x4*)(sp + c) = g * acc[ai][bj][m][n]; }
                } else {
#pragma unroll
                for (int bj = 0; bj < 2; ++bj)
#pragma unroll
                    for (int n = 0; n < 2; ++n) { const int c = col0 + bj * HALF + n * 16;
                        const f32x4 b = *(const f32x4*)(bp + c), g = *(const f32x4*)(gp + c);
                        *(f32x4*)(op + c) = b + g * acc[ai][bj][m][n]; }
                }
                asm volatile("" ::: "memory");
            }
    }
};

struct EpiSwiGLU {
    static constexpr bool PERM = true, AFTER_DRAIN = false;
    bf16_t* O;
    __device__ __forceinline__ void operator()(const f32x4 (&acc)[2][2][4][2], const Unit& u, int wr, int wc, int fr, int fq) const {
        const int row0 = u.pm * BM + wr * 64 + fr, col0 = u.pn * HALF + wc * 32 + 8 * fq;
#pragma unroll
        for (int ai = 0; ai < 2; ++ai)
#pragma unroll
            for (int m = 0; m < 4; ++m) { bf16_t* rowp = O + (size_t)(row0 + ai * HALF + m * 16) * FF + col0;
                f32x4 o0, o1;
#pragma unroll
                for (int e = 0; e < 4; ++e) { const float g0 = acc[ai][0][m][0][e], g1 = acc[ai][0][m][1][e];
                    o0[e] = g0 * fast_sigmoid(g0) * acc[ai][1][m][0][e]; o1[e] = g1 * fast_sigmoid(g1) * acc[ai][1][m][1][e]; }
                u32x4 w; w.x = cvt_pk_bf16(o0[0], o0[1]); w.y = cvt_pk_bf16(o0[2], o0[3]); w.z = cvt_pk_bf16(o1[0], o1[1]); w.w = cvt_pk_bf16(o1[2], o1[3]);
                *(u32x4*)rowp = w; }
    }
};

struct EpiKVQ {
    static constexpr bool PERM = true, AFTER_DRAIN = false;
    bf16_t* KB; bf16_t* VB; bf16_t* QB; const float* rope; float* dout;
    __device__ __forceinline__ void operator()(const f32x4 (&acc)[2][2][4][2], const Unit& u, int wr, int wc, int fr, int fq) const {
        const int tile = u.pn, cl = wc * 32 + 8 * fq;
        const bool rot_wave = (tile != 1) && ((wc & 1) == 0);
        const float sg = (fq == 0) ? -1.f : 1.f;
#pragma unroll
        for (int ai = 0; ai < 2; ++ai)
#pragma unroll
            for (int m = 0; m < 4; ++m) {
                const int r = u.pm * BM + ai * HALF + wr * 64 + m * 16 + fr;
                const bool samp = r >= MP;
                const int pidx = samp ? (2048 + ((r - MP) & 7)) : (r & 2047);
                f32x4 cs0 = {1.f, 1.f, 1.f, 1.f}, cs1 = cs0, sn0 = {0.f, 0.f, 0.f, 0.f}, sn1 = sn0;
                if (rot_wave) { const float* rp = rope + (size_t)pidx * 16; cs0 = *(const f32x4*)rp; cs1 = *(const f32x4*)(rp + 4); sn0 = *(const f32x4*)(rp + 8); sn1 = *(const f32x4*)(rp + 12); }
#pragma unroll
                for (int bj = 0; bj < 2; ++bj) {
                    f32x4 v0 = acc[ai][bj][m][0], v1 = acc[ai][bj][m][1];
                    if (rot_wave) {
                        f32x4 o0, o1;
#pragma unroll
                        for (int e = 0; e < 4; ++e) { o0[e] = __shfl_xor(v0[e], 16); o1[e] = __shfl_xor(v1[e], 16); }
                        if (fq < 2) { v0 = v0 * cs0 + (o0 * sg) * sn0; v1 = v1 * cs1 + (o1 * sg) * sn1; }
                    }
                    const int c = bj * HALF + cl;
                    if (tile < 2) {
                        bf16_t* dst = (tile == 0 ? KB : VB) + (size_t)r * 256 + c;
                        u32x4 w; w.x = cvt_pk_bf16(v0[0], v0[1]); w.y = cvt_pk_bf16(v0[2], v0[3]); w.z = cvt_pk_bf16(v1[0], v1[1]); w.w = cvt_pk_bf16(v1[2], v1[3]);
                        *(u32x4*)dst = w;
                        if (samp) { const int bs = (r - MP) >> 3, ts = (r - MP) & 7;
                            float* wp = dout + (tile == 0 ? O_SK : O_SV) + ((size_t)bs * 128 + 120 + ts) * 256 + c;
                            *(f32x4*)wp = v0; *(f32x4*)(wp + 4) = v1;
                        } else if ((r & 2047) >= 1920) { const int b = r >> 11, j = (r & 2047) - 1920;
                            float* wp = dout + (tile == 0 ? O_PK : O_PV) + ((size_t)b * 128 + j) * 256 + c;
                            *(f32x4*)wp = v0; *(f32x4*)(wp + 4) = v1;
                        }
                    } else {
                        v0 = v0 * QSCALE; v1 = v1 * QSCALE;
                        bf16_t* dst = QB + (size_t)r * DM + (tile - 2) * BM + c;
                        u32x4 w; w.x = cvt_pk_bf16(v0[0], v0[1]); w.y = cvt_pk_bf16(v0[2], v0[3]); w.z = cvt_pk_bf16(v1[0], v1[1]); w.w = cvt_pk_bf16(v1[2], v1[3]);
                        *(u32x4*)dst = w;
                    }
                }
            }
    }
};

template <class Epi, class Sched, bool ALIGN_EPI = false, bool SP2 = false>
__device__ __forceinline__ void gemm_phase(PG8_LAS unsigned char* lds, const Gemm g, const Sched& S, const Epi& E) {
    const int tid = threadIdx.x, wid = __builtin_amdgcn_readfirstlane(tid >> 6), lane = tid & 63, wr = wid >> 2, wc = wid & 3, fr = lane & 15, fq = lane >> 4;
    const int K = g.K;
    unsigned voffA[2], voffB[2];
#pragma unroll
    for (int i = 0; i < 2; ++i) { int R, C; stage_rc(tid * 16 + i * 8192, R, C); const int Rb = Epi::PERM ? ((R & ~31) + perm32(R & 31)) : R;
        voffA[i] = (unsigned)(R * K + C) * 2u; voffB[i] = (unsigned)(Rb * K + C) * 2u; }
    const size_t kstep = (size_t)(BK * 2);
    const size_t hstep = (size_t)HALF * K * 2;
    const size_t tstep = 2 * hstep;
    const unsigned ldsw = (unsigned)wid * 1024u;
    const int aoff = lds_byte(wr * 64 + fr, fq * 8), boff = lds_byte(wc * 32 + fr, fq * 8);
#define PG8_SA(b, h) (((b) * 2 + (h)) * HTB)
#define PG8_SB(b, h) ((4 + (b) * 2 + (h)) * HTB)
#define PG8_STAGE(bufoff, gbase, voff) do { _Pragma("unroll") for (int _i = 0; _i < 2; ++_i) \
        __builtin_amdgcn_global_load_lds((const unsigned*)((const char*)(gbase) + (voff)[_i]), (PG8_LAS unsigned*)(lds + (bufoff) + ldsw + _i * 8192), 16, 0, 0); } while (0)
#define PG8_LDA(dst, b, h) do { _Pragma("unroll") for (int m = 0; m < 4; ++m) _Pragma("unroll") for (int k = 0; k < 2; ++k) dst[m][k] = *(const PG8_LAS bf16x8*)(lds + PG8_SA(b, h) + aoff + m * 2048 + k * 1024); } while (0)
#define PG8_LDB(dst, b, h) do { _Pragma("unroll") for (int n = 0; n < 2; ++n) _Pragma("unroll") for (int k = 0; k < 2; ++k) dst[n][k] = *(const PG8_LAS bf16x8*)(lds + PG8_SB(b, h) + boff + n * 2048 + k * 1024); } while (0)
#define PG8_MMA(ai, bj, At, Bt) do { __builtin_amdgcn_s_setprio(1); _Pragma("unroll") for (int m = 0; m < 4; ++m) _Pragma("unroll") for (int n = 0; n < 2; ++n) _Pragma("unroll") for (int k = 0; k < 2; ++k) \
        acc[ai][bj][m][n] = __builtin_amdgcn_mfma_f32_16x16x32_bf16(Bt[n][k], At[m][k], acc[ai][bj][m][n], 0, 0, 0); __builtin_amdgcn_s_setprio(0); } while (0)
#define PG8_WAIT_V(n) asm volatile("s_waitcnt vmcnt(" #n ")" ::: "memory")
#define PG8_WAIT_L(n) asm volatile("s_waitcnt lgkmcnt(" #n ")" ::: "memory")
#define PG8_BAR __builtin_amdgcn_s_barrier()
#define PG8_SCHED __builtin_amdgcn_sched_barrier(0)
    Unit cur, nxt; int ui = 0;
    if (!S.next(0, cur)) return;
    f32x4 acc[2][2][4][2];
#pragma unroll
    for (int a = 0; a < 2; ++a)
#pragma unroll
        for (int b = 0; b < 2; ++b)
#pragma unroll
            for (int m = 0; m < 4; ++m)
#pragma unroll
                for (int n = 0; n < 2; ++n) acc[a][b][m][n] = (f32x4){0.f, 0.f, 0.f, 0.f};
    bf16x8 At[4][2], B0[2][2], B1[2][2];
    const char* cA = (const char*)(cur.pn < g.pn_split ? g.A : g.A2) + (size_t)cur.pm * tstep + (size_t)cur.k0 * (BK * 2); const char* cB = (const char*)g.Bt + (size_t)cur.pn * tstep + (size_t)cur.k0 * (BK * 2);
    S.a_ready(cur);
    if constexpr (SP2) {
        PG8_STAGE(PG8_SB(0, 0), cB, voffB); PG8_STAGE(PG8_SB(0, 1), cB + hstep, voffB); PG8_STAGE(PG8_SA(0, 0), cA, voffA); PG8_STAGE(PG8_SA(0, 1), cA + hstep, voffA);
        if (wr == 1) PG8_BAR;
        PG8_WAIT_V(2); PG8_BAR;
        PG8_STAGE(PG8_SB(1, 0), cB + kstep, voffB); PG8_STAGE(PG8_SA(1, 0), cA + kstep, voffA); PG8_STAGE(PG8_SB(1, 1), cB + hstep + kstep, voffB);
        PG8_WAIT_V(6); PG8_BAR;
    } else {
        PG8_STAGE(PG8_SB(0, 0), cB, voffB); PG8_STAGE(PG8_SA(0, 0), cA, voffA); PG8_STAGE(PG8_SB(0, 1), cB + hstep, voffB); PG8_STAGE(PG8_SA(0, 1), cA + hstep, voffA);
        if (wr == 1) PG8_BAR;
        PG8_WAIT_V(4); PG8_BAR;
        PG8_STAGE(PG8_SB(1, 0), cB + kstep, voffB); PG8_STAGE(PG8_SA(1, 0), cA + kstep, voffA); PG8_STAGE(PG8_SB(1, 1), cB + hstep + kstep, voffB);
        PG8_WAIT_V(6); PG8_BAR;
    }
    for (;;) {
        const bool has_next = S.next(ui + 1, nxt);
        const char* nA = has_next ? (const char*)(nxt.pn < g.pn_split ? g.A : g.A2) + (size_t)nxt.pm * tstep + (size_t)nxt.k0 * (BK * 2) : cA; const char* nB = has_next ? (const char*)g.Bt + (size_t)nxt.pn * tstep + (size_t)nxt.k0 * (BK * 2) : cB;
        const int nt = cur.nt;
        for (int t = 0; t < nt; t += 2) {
            const bool last = (t == nt - 2);
            const char* a1 = cA + (size_t)(t + 1) * kstep;
            const char* a2 = last ? nA : cA + (size_t)(t + 2) * kstep; const char* b2 = last ? nB : cB + (size_t)(t + 2) * kstep;
            const char* a3 = a2 + kstep; const char* b3 = b2 + kstep;
            if (last && has_next) S.a_ready(nxt);
            if constexpr (SP2) {
            PG8_LDB(B0, 0, 0); PG8_LDB(B1, 0, 1); PG8_SCHED; PG8_LDA(At, 0, 0); PG8_STAGE(PG8_SA(1, 1), a1 + hstep, voffA);
            PG8_WAIT_V(8); PG8_WAIT_L(0); PG8_BAR; PG8_MMA(0, 0, At, B0); PG8_MMA(0, 1, At, B1); PG8_BAR; PG8_SCHED;
            PG8_LDA(At, 0, 1); PG8_STAGE(PG8_SB(0, 0), b2, voffB); PG8_STAGE(PG8_SB(0, 1), b2 + hstep, voffB); PG8_STAGE(PG8_SA(0, 0), a2, voffA);
            PG8_WAIT_V(8); PG8_WAIT_L(0); PG8_BAR; PG8_MMA(1, 0, At, B0); PG8_MMA(1, 1, At, B1); PG8_BAR; PG8_SCHED;
            PG8_LDB(B0, 1, 0); PG8_LDB(B1, 1, 1); PG8_SCHED; PG8_LDA(At, 1, 0); PG8_STAGE(PG8_SA(0, 1), a2 + hstep, voffA);
            PG8_WAIT_V(8); PG8_WAIT_L(0); PG8_BAR; PG8_MMA(0, 0, At, B0); PG8_MMA(0, 1, At, B1); PG8_BAR; PG8_SCHED;
            PG8_LDA(At, 1, 1); PG8_STAGE(PG8_SB(1, 0), b3, voffB); PG8_STAGE(PG8_SB(1, 1), b3 + hstep, voffB); PG8_STAGE(PG8_SA(1, 0), a3, voffA);
            PG8_WAIT_V(8); PG8_WAIT_L(0); PG8_BAR; PG8_MMA(1, 0, At, B0); PG8_MMA(1, 1, At, B1); PG8_BAR; PG8_SCHED;
            } else {
            PG8_LDB(B0, 0, 0); PG8_SCHED; PG8_LDA(At, 0, 0); PG8_STAGE(PG8_SA(1, 1), a1 + hstep, voffA);
            PG8_WAIT_L(8); PG8_BAR; PG8_WAIT_L(0); PG8_MMA(0, 0, At, B0); PG8_BAR; PG8_SCHED;
            PG8_LDB(B1, 0, 1); PG8_STAGE(PG8_SB(0, 0), b2, voffB);
            PG8_BAR; PG8_WAIT_L(0); PG8_MMA(0, 1, At, B1); PG8_BAR;
            PG8_LDA(At, 0, 1); PG8_STAGE(PG8_SA(0, 0), a2, voffA);
            PG8_BAR; PG8_WAIT_L(0); PG8_MMA(1, 0, At, B0); PG8_BAR; PG8_SCHED;
            PG8_STAGE(PG8_SB(0, 1), b2 + hstep, voffB);
            PG8_WAIT_V(6); PG8_BAR; PG8_MMA(1, 1, At, B1); PG8_BAR;
            PG8_LDB(B0, 1, 0); PG8_SCHED; PG8_LDA(At, 1, 0); PG8_STAGE(PG8_SA(0, 1), a2 + hstep, voffA);
            PG8_WAIT_L(8); PG8_BAR; PG8_WAIT_L(0); PG8_MMA(0, 0, At, B0); PG8_BAR; PG8_SCHED;
            PG8_LDB(B1, 1, 1); PG8_STAGE(PG8_SB(1, 0), b3, voffB);
            PG8_BAR; PG8_WAIT_L(0); PG8_MMA(0, 1, At, B1); PG8_BAR;
            PG8_LDA(At, 1, 1); PG8_STAGE(PG8_SA(1, 0), a3, voffA);
            PG8_BAR; PG8_WAIT_L(0); PG8_MMA(1, 0, At, B0); PG8_BAR; PG8_SCHED;
            PG8_STAGE(PG8_SB(1, 1), b3 + hstep, voffB);
            PG8_WAIT_V(6); PG8_BAR; PG8_MMA(1, 1, At, B1); PG8_BAR;
            }
        }
        if constexpr (ALIGN_EPI) { if (wr == 0) PG8_BAR; }
        if constexpr (!Epi::AFTER_DRAIN) { E(acc, cur, wr, wc, fr, fq); S.done(cur); }
        if (!has_next) break;
#pragma unroll
        for (int a = 0; a < 2; ++a)
#pragma unroll
            for (int b = 0; b < 2; ++b)
#pragma unroll
                for (int m = 0; m < 4; ++m)
#pragma unroll
                    for (int n = 0; n < 2; ++n) acc[a][b][m][n] = (f32x4){0.f, 0.f, 0.f, 0.f};
        cur = nxt; cA = nA; cB = nB; ++ui;
        if constexpr (ALIGN_EPI) { if (wr == 1) PG8_BAR; }
    }
    PG8_WAIT_V(0);
    if constexpr (!ALIGN_EPI) { if (wr == 0) PG8_BAR; }
    PG8_BAR;
    if constexpr (Epi::AFTER_DRAIN) { E.fused(acc, cur, wr, wc, fr, fq, lds, wid, lane); S.done(cur); }
#undef PG8_SA
#undef PG8_SB
#undef PG8_STAGE
#undef PG8_LDA
#undef PG8_LDB
#undef PG8_MMA
#undef PG8_WAIT_V
#undef PG8_WAIT_L
#undef PG8_BAR
#undef PG8_SCHED
}
}

#define GAS __attribute__((address_space(1)))
#define LAS __attribute__((address_space(3)))
typedef unsigned short bf16;
typedef unsigned v4u __attribute__((ext_vector_type(4)));
typedef float f32x4 __attribute__((ext_vector_type(4)));
typedef short bf16x8 __attribute__((ext_vector_type(8)));
typedef GAS unsigned gu32;
typedef GAS unsigned long long gu64;
#define RLX_AGENT __ATOMIC_RELAXED, __HIP_MEMORY_SCOPE_AGENT
#define LDS_WAIT() asm volatile("s_waitcnt lgkmcnt(0)" ::: "memory")
#define VM_WAIT() asm volatile("s_waitcnt vmcnt(0)" ::: "memory")
__device__ __forceinline__ unsigned long long rt() { return __builtin_amdgcn_s_memrealtime(); }
__device__ __forceinline__ unsigned f2bf(float f) { unsigned u = __builtin_bit_cast(unsigned, f); return (u + 0x7fffu + ((u >> 16) & 1u)) >> 16; }
typedef float pk_f32x2 __attribute__((ext_vector_type(2))); typedef __bf16 pk_bf16x2 __attribute__((ext_vector_type(2)));
__device__ __forceinline__ unsigned pk2(float lo, float hi) { pk_f32x2 v = {lo, hi}; pk_bf16x2 b = __builtin_convertvector(v, pk_bf16x2); return __builtin_bit_cast(unsigned, b); }

#define XB_TMO      128
#define XB_XCNT(j)  (256  + 64 * (j))
#define XB_XSUB(j)  (1280 + 64 * (j))
#define XB_XGEN(j)  (2304 + 64 * (j))
#define XB_TOP      3328
#define XB_TOPGEN   3392
#define XCD_BAR_WORDS 3456
#define XB_SPIN_CAP (1u << 18)

__device__ __forceinline__ unsigned xb_ld(unsigned* p)              { return __hip_atomic_load(p, __ATOMIC_RELAXED, __HIP_MEMORY_SCOPE_AGENT); }
__device__ __forceinline__ unsigned xb_add(unsigned* p, unsigned v) { return __hip_atomic_fetch_add(p, v, __ATOMIC_RELAXED, __HIP_MEMORY_SCOPE_AGENT); }
__device__ __forceinline__ unsigned xb_xcc_id() { return (unsigned)__builtin_amdgcn_s_getreg((3 << 11) | 20) & 0xFu; }
#define XB_SPIN(cond, bar) do { unsigned _sp = 0; while (cond) { __builtin_amdgcn_s_sleep(1); \
    if ((++_sp & 255u) == 0u) { if (xb_ld(&(bar)[XB_TMO])) break; if (_sp > XB_SPIN_CAP) { atomicAdd(&(bar)[XB_TMO], 1u); break; } } } } while (0)

struct XcdBarrier {
    unsigned* bar; unsigned x;
    volatile LAS unsigned* st;
};

__device__ __forceinline__ XcdBarrier xcd_barrier_post(unsigned* bar, volatile LAS unsigned* st) {
    XcdBarrier b; b.bar = bar; b.x = xb_xcc_id(); b.st = st;
    if (threadIdx.x == 0) (void)xb_add(&bar[XB_XCNT(b.x)], 1u);
    return b;
}
__device__ __forceinline__ void xcd_barrier_complete(unsigned* bar, unsigned x, unsigned& nloc, unsigned& nx) {
    const unsigned G = gridDim.x * gridDim.y * gridDim.z;
    unsigned sum, cnt, mine, sp = 0u;
    for (;;) {
        sum = 0u; cnt = 0u; mine = 0u;
#pragma unroll
        for (unsigned j = 0; j < 16; ++j) { const unsigned c = xb_ld(&bar[XB_XCNT(j)]); sum += c; cnt += (c > 0u) ? 1u : 0u; mine = (j == x) ? c : mine; }
        if (sum == G) break;
        __builtin_amdgcn_s_sleep(1);
        if ((++sp & 255u) == 0u) { if (xb_ld(&bar[XB_TMO])) break; if (sp > XB_SPIN_CAP) { atomicAdd(&bar[XB_TMO], 1u); break; } }
    }
    nloc = mine > 0u ? mine : 1u; nx = cnt > 0u ? cnt : 1u;
}

__device__ __forceinline__ void xcd_barrier(const XcdBarrier& b) {
    asm volatile("s_waitcnt vmcnt(0)" ::: "memory");
    __syncthreads();
    if (threadIdx.x == 0) {
        unsigned* bar = b.bar;
        __builtin_amdgcn_s_waitcnt(0);
        unsigned nloc = b.st[0], nx = b.st[1];
        if (nloc == 0u) { xcd_barrier_complete(bar, b.x, nloc, nx); b.st[0] = nloc; b.st[1] = nx; }
        const unsigned old = xb_add(&bar[XB_XSUB(b.x)], 1u);
        const unsigned gen = old / nloc;
        if (old + 1u == (gen + 1u) * nloc) {
            __builtin_amdgcn_fence(__ATOMIC_RELEASE, "agent");
            asm volatile("s_waitcnt vmcnt(0)" ::: "memory");
            const unsigned og = xb_add(&bar[XB_TOP], 1u);
            const unsigned tg = og / nx;
            if (og + 1u == (tg + 1u) * nx) xb_add(&bar[XB_TOPGEN], 1u);
            else XB_SPIN(xb_ld(&bar[XB_TOPGEN]) == tg, bar);
            __builtin_amdgcn_fence(__ATOMIC_ACQUIRE, "agent");
            xb_add(&bar[XB_XGEN(b.x)], 1u);
            asm volatile("s_waitcnt vmcnt(0)" ::: "memory");
        } else {
            XB_SPIN(xb_ld(&bar[XB_XGEN(b.x)]) == gen, bar);
            __builtin_amdgcn_fence(__ATOMIC_ACQUIRE, "agent");
            asm volatile("s_waitcnt vmcnt(0)" ::: "memory");
        }
    }
    __syncthreads();
}

constexpr size_t MiB = 1u << 20;
constexpr size_t WS_CTL = 0, CTL_ZERO_BYTES = 1 * MiB;
constexpr size_t WS_ROPE = 1 * MiB;
constexpr size_t WS_WGF = 1 * MiB + 256 * 1024;
constexpr size_t WS_SC = 2 * MiB;
constexpr size_t WS_MODS = 3 * MiB;
constexpr size_t WS_WADA = 17 * MiB, WS_WIN = 45 * MiB, WS_WOUT = 49 * MiB, WS_WKVQ = 51 * MiB, WS_WO = 54 * MiB, WS_WFI = 56 * MiB, WS_WFO = 78 * MiB;
constexpr size_t WFI_BYTES = 11 * MiB, WFO_BYTES = 5 * MiB + 512 * 1024;
constexpr size_t WS_C = 89 * MiB;
constexpr size_t WS_B = 123 * MiB;
constexpr size_t ACT_ROWS_BYTES = (size_t)MT * DM * 2;
constexpr size_t WS_XR = WS_B, WS_YG = WS_B + ACT_ROWS_BYTES, WS_ACT = WS_B;
constexpr size_t WS_HK = WS_B, WS_Q = WS_B + ACT_ROWS_BYTES, WS_K = WS_B + 2 * ACT_ROWS_BYTES, WS_V = WS_K + (size_t)MT * 256 * 2;
constexpr size_t WS_SLAB = WS_B + (size_t)MT * FF * 2;
constexpr size_t WS_END = WS_SLAB + (size_t)5 * MS * DM * 4;
static_assert(WS_V + (size_t)MT * 256 * 2 <= WS_SLAB && WS_END <= 256 * MiB && WS_WFO + 2 * WFO_BYTES <= WS_C && WS_C + ACT_ROWS_BYTES <= WS_B, "d_ws map");
constexpr int CW_BAR = 4096;

constexpr int RING_OFF = 0, RING_BYTES = 131072;
constexpr int LDSCTL_OFF = RING_BYTES, MISC_OFF = LDSCTL_OFF + 320;
constexpr int LDS_BYTES = 147456;
constexpr int NWAVES = 8, NPHASE = 17;

struct Args { const float* in[28]; float* out; unsigned char* ws; int ph_lo, ph_hi, dry, pad; float inv[8]; };

struct Frame {
    LAS unsigned char* lds;
    int tid, lane, wave, G, bx;
};

__device__ __forceinline__ float wave_sum(float v) {
#pragma unroll
    for (int o = 1; o < 64; o <<= 1) v += __shfl_xor(v, o);
    return v;
}
__device__ __forceinline__ float fast_sig(float x) { return __builtin_amdgcn_rcpf(1.0f + __builtin_amdgcn_exp2f(-1.4426950408889634f * x)); }
__device__ __forceinline__ float bf2f(unsigned short h) { return __builtin_bit_cast(float, (unsigned)h << 16); }
__device__ __forceinline__ float bflo(unsigned w) { return __builtin_bit_cast(float, w << 16); }
__device__ __forceinline__ float bfhi(unsigned w) { return __builtin_bit_cast(float, w & 0xffff0000u); }

__device__ __forceinline__ void p0_transpose_item(const float* W, int K, int N, bf16* WT, int row_off, int mode, LAS float* scr, int item, int lane) {
    const int nblk = N / 32, kb = item / nblk, nb = item % nblk, k0 = 64 * kb, n0 = 32 * nb;
#pragma unroll 8
    for (int i = 0; i < 32; ++i) { const int kk = 2 * i + (lane >> 5); scr[kk * 33 + (lane & 31)] = W[(size_t)(k0 + kk) * N + n0 + (lane & 31)]; }
    LDS_WAIT(); asm volatile("" ::: "memory");
    int d0;
    if (mode == 0) d0 = row_off + n0; else { const int f = n0 < FF ? n0 : n0 - FF; d0 = 256 * (f >> 7) + (f & 127) + (n0 < FF ? 0 : 128); }
    const int c = lane & 7;
#pragma unroll
    for (int j = 0; j < 4; ++j) { const int n = (lane >> 3) + 8 * j; const LAS float* s = scr + (8 * c) * 33 + n;
        v4u o; o.x = pk2(s[0 * 33], s[1 * 33]); o.y = pk2(s[2 * 33], s[3 * 33]); o.z = pk2(s[4 * 33], s[5 * 33]); o.w = pk2(s[6 * 33], s[7 * 33]);
        *(GAS v4u*)(WT + (size_t)(d0 + n) * K + k0 + 8 * c) = o; }
    LDS_WAIT(); asm volatile("" ::: "memory");
}

__device__ __forceinline__ void p0_prologue(Frame& F, const Args& A) {
    LAS float* scr = (LAS float*)(F.lds + RING_OFF + F.wave * 16384);
    const int gw = F.bx * NWAVES + F.wave, NGW = F.G * NWAVES;
    unsigned char* ws = A.ws;
    bf16* WADA = (bf16*)(ws + WS_WADA); bf16* WIN = (bf16*)(ws + WS_WIN); bf16* WOUT = (bf16*)(ws + WS_WOUT); bf16* WKVQ = (bf16*)(ws + WS_WKVQ); bf16* WO = (bf16*)(ws + WS_WO);
    constexpr int I_ADA = 16 * 192, I_KVA = 16 * 64, I_IN = 16 * 64, I_SQ = 16 * 32, I_KV = 16 * 16, I_FI = 16 * 176, I_FO = 44 * 32;
    constexpr int NITEMS = 2 * I_ADA + I_KVA + I_IN + I_SQ + I_KV + I_SQ + I_SQ + 2 * I_FI + 2 * I_FO;
    for (int it = gw; it < NITEMS; it += NGW) {
        int r = it;
        if (r < I_ADA) { p0_transpose_item(A.in[8], 1024, 6144, WADA, 0, 0, scr, r, F.lane); continue; } r -= I_ADA;
        if (r < I_ADA) { p0_transpose_item(A.in[8] + (size_t)1024 * 6144, 1024, 6144, WADA, 6144, 0, scr, r, F.lane); continue; } r -= I_ADA;
        if (r < I_KVA) { p0_transpose_item(A.in[18], 1024, 2048, WADA, 12288, 0, scr, r, F.lane); continue; } r -= I_KVA;
        if (r < I_IN) { p0_transpose_item(A.in[11], 1024, 2048, WIN, 0, 0, scr, r, F.lane); continue; } r -= I_IN;
        if (r < I_SQ) { p0_transpose_item(A.in[17], 1024, 1024, WOUT, 0, 0, scr, r, F.lane); continue; } r -= I_SQ;
        if (r < I_KV) { p0_transpose_item(A.in[21], 1024, 512, WKVQ, 0, 0, scr, r, F.lane); continue; } r -= I_KV;
        if (r < I_SQ) { p0_transpose_item(A.in[22], 1024, 1024, WKVQ, 512, 0, scr, r, F.lane); continue; } r -= I_SQ;
        if (r < I_SQ) { p0_transpose_item(A.in[24], 1024, 1024, WO, 0, 0, scr, r, F.lane); continue; } r -= I_SQ;
        if (r < I_FI) { p0_transpose_item(A.in[25], 1024, 5632, (bf16*)(ws + WS_WFI), 0, 1, scr, r, F.lane); continue; } r -= I_FI;
        if (r < I_FI) { p0_transpose_item(A.in[25] + (size_t)1024 * 5632, 1024, 5632, (bf16*)(ws + WS_WFI + WFI_BYTES), 0, 1, scr, r, F.lane); continue; } r -= I_FI;
        if (r < I_FO) { p0_transpose_item(A.in[26], 2816, 1024, (bf16*)(ws + WS_WFO), 0, 0, scr, r, F.lane); continue; } r -= I_FO;
        p0_transpose_item(A.in[26] + (size_t)2816 * 1024, 2816, 1024, (bf16*)(ws + WS_WFO + WFO_BYTES), 0, 0, scr, r, F.lane);
    }
    const int gt = F.bx * (NWAVES * 64) + F.tid, NGT = F.G * NWAVES * 64;
    { bf16* SC = (bf16*)(ws + WS_SC);
      for (int i = gt; i < 256 * 256; i += NGT) { const int row = i >> 8, c4 = (i & 255) * 4; f32x4 v = {0.f, 0.f, 0.f, 0.f};
          if (row < NCOND) { v = *(const f32x4*)((row < 8 ? A.in[2] + (size_t)row * DM : A.in[3] + (size_t)(row - 8) * DM) + c4);
#pragma unroll
              for (int e = 0; e < 4; ++e) v[e] = v[e] / (1.0f + __expf(-v[e])); }
          uint2 o; o.x = pk2(v[0], v[1]); o.y = pk2(v[2], v[3]); *(uint2*)(SC + (size_t)row * DM + c4) = o; } }
    { v4u* WGF = (v4u*)(ws + WS_WGF);
      for (int i = gt; i < 32 * 16 * 64; i += NGT) { const int ln = i & 63, f = (i >> 6) & 15, mt = f >> 2, ks = f & 3, grp = i >> 10, n = grp >> 2, q = grp & 3, r16 = ln & 15, kq = ln >> 4;
          const int col = (mt >> 1) * 128 + q * 32 + 8 * (r16 >> 2) + (r16 & 3) + 4 * (mt & 1);
          const float* gp = A.in[14] + ((size_t)n * 128 + ks * 32 + kq * 8) * 256 + col;
          v4u o; o.x = pk2(gp[0], gp[256]); o.y = pk2(gp[512], gp[768]); o.z = pk2(gp[1024], gp[1280]); o.w = pk2(gp[1536], gp[1792]); WGF[i] = o; } }
    { float* RT = (float*)(ws + WS_ROPE);
      for (int i = gt; i < 2056 * 8; i += NGT) { const int pi = i >> 3, f = i & 7; const int pos = pi < 2048 ? pi : 16384 + (pi - 2048);
          const float invf = f == 0 ? A.inv[0] : f == 1 ? A.inv[1] : f == 2 ? A.inv[2] : f == 3 ? A.inv[3] : f == 4 ? A.inv[4] : f == 5 ? A.inv[5] : f == 6 ? A.inv[6] : A.inv[7];
          const float ang = (float)pos * invf;
          const double x = (double)ang; const double k = __builtin_rint(x * 0.15915494309189535); const double rr = x - k * 6.283185307179586;
          const double r2 = rr * rr; double ts = rr, tc = 1.0, ss = rr, cc = 1.0;
#pragma unroll 1
          for (int n = 1; n <= 14; ++n) { tc = -tc * r2 / (double)((2 * n - 1) * (2 * n)); ts = -ts * r2 / (double)((2 * n) * (2 * n + 1)); cc += tc; ss += ts; }
          RT[pi * 16 + f] = (float)cc; RT[pi * 16 + 8 + f] = (float)ss; } }
    { const f32x4* ck = (const f32x4*)A.in[6]; const f32x4* cv = (const f32x4*)A.in[7]; f32x4* ok = (f32x4*)(A.out + O_SK); f32x4* ov = (f32x4*)(A.out + O_SV);
      for (int i = gt; i < 128 * 120 * 64; i += NGT) { const int b = i / (120 * 64), rem = i - b * (120 * 64);
          ok[(size_t)b * 128 * 64 + rem] = ck[(size_t)b * 128 * 64 + 8 * 64 + rem]; ov[(size_t)b * 128 * 64 + rem] = cv[(size_t)b * 128 * 64 + 8 * 64 + rem]; } }
}

__device__ __forceinline__ const float* xs_row(const Args& A, int r, bool from_input) {
    if (from_input) return r < MP ? A.in[0] + (size_t)r * DM : A.in[1] + (size_t)(r - MP) * DM;
    return A.out + (size_t)r * DM;
}
__device__ __forceinline__ void row_load(const float* xrow, int lane, f32x4 (&v)[4], float& rstd) {
    const f32x4* xr = (const f32x4*)xrow + lane; float s = 0.f;
#pragma unroll
    for (int j = 0; j < 4; ++j) { v[j] = xr[64 * j]; s += (v[j].x * v[j].x + v[j].y * v[j].y) + (v[j].z * v[j].z + v[j].w * v[j].w); }
    rstd = 1.0f / sqrtf(wave_sum(s) * (1.0f / DM) + EPS);
}
template <int NSLAB>
__device__ __forceinline__ void row_load_slabs(const Args& A, int r, int lane, f32x4 (&v)[4], float& rstd) {
    f32x4* xr = (f32x4*)(A.out + (size_t)r * DM) + lane; const f32x4* sl = (const f32x4*)(A.ws + WS_SLAB) + (size_t)(r - MP) * (DM / 4) + lane; float s = 0.f;
    f32x4 t[NSLAB > 0 ? NSLAB : 1][4];
#pragma unroll
    for (int j = 0; j < 4; ++j) { v[j] = xr[64 * j];
#pragma unroll
        for (int k = 0; k < NSLAB; ++k) t[k][j] = sl[(size_t)k * MS * (DM / 4) + 64 * j]; }
#pragma unroll
    for (int j = 0; j < 4; ++j) { f32x4 x = v[j];
#pragma unroll
        for (int k = 0; k < NSLAB; ++k) x += t[k][j];
        if (!A.dry) xr[64 * j] = x; v[j] = x; s += (x.x * x.x + x.y * x.y) + (x.z * x.z + x.w * x.w); }
    rstd = 1.0f / sqrtf(wave_sum(s) * (1.0f / DM) + EPS);
}
__device__ __forceinline__ void row_mod_store(const f32x4 (&v)[4], float rstd, const float* g, const float* sh, const float* sc, bf16* orow, int lane) {
#pragma unroll
    for (int j = 0; j < 4; ++j) { const int c = 4 * lane + 256 * j;
        const f32x4 gg = *(const f32x4*)(g + c), s = *(const f32x4*)(sh + c), k = *(const f32x4*)(sc + c);
        f32x4 y = (v[j] * rstd) * gg; y = y * (k + 1.0f) + s;
        uint2 o; o.x = pk2(y[0], y[1]); o.y = pk2(y[2], y[3]); *(uint2*)(orow + c) = o; }
}
template <int NSLAB>
__device__ __forceinline__ void norm_phase(Frame& F, const Args& A, bool from_input, const float* g, int off_sh, int off_sc, bf16* H, const float* g2, int off_sh2, int off_sc2, bf16* H2) {
    const int gw = F.bx * NWAVES + F.wave, NGW = F.G * NWAVES;
    const float* MODS = (const float*)(A.ws + WS_MODS);
    int lane_ = F.lane; asm volatile("" : "+v"(lane_));
    Frame Fl = F; Fl.lane = lane_;
    for (int r = gw; r < MT; r += NGW) {
        f32x4 v[4]; float rstd;
        if (NSLAB > 0 && r >= MP) row_load_slabs<NSLAB>(A, r, Fl.lane, v, rstd); else row_load(xs_row(A, r, from_input), Fl.lane, v, rstd);
        if (from_input && r >= MP) { f32x4* xo = (f32x4*)(A.out + (size_t)r * DM) + Fl.lane;
#pragma unroll
            for (int j = 0; j < 4; ++j) xo[64 * j] = v[j]; }
        const float* mrow = MODS + (size_t)cond_row(r) * NMOD;
        row_mod_store(v, rstd, g, mrow + off_sh, mrow + off_sc, H + (size_t)r * DM, Fl.lane);
        if (H2) row_mod_store(v, rstd, g2, mrow + off_sh2, mrow + off_sc2, H2 + (size_t)r * DM, Fl.lane);
    }
}
template <int NSLAB>
__device__ __forceinline__ void final_norm_phase(Frame& F, const Args& A, const float* g) {
    const int gw = F.bx * NWAVES + F.wave, NGW = F.G * NWAVES;
    int lane_ = F.lane; asm volatile("" : "+v"(lane_));
    Frame Fl = F; Fl.lane = lane_;
    for (int r = gw; r < MT; r += NGW) {
        float* xrow = A.out + (size_t)r * DM; f32x4 v[4]; float rstd; if (r >= MP) row_load_slabs<NSLAB>(A, r, Fl.lane, v, rstd); else row_load(xrow, Fl.lane, v, rstd);
#pragma unroll
        for (int j = 0; j < 4; ++j) { const int c = 4 * Fl.lane + 256 * j; const f32x4 gg = *(const f32x4*)(g + c); if (!A.dry) *(f32x4*)(xrow + c) = (v[j] * rstd) * gg; }
    }
}

constexpr int RNN_STG_ROW = 272;
constexpr int RNN_STG_WAVE = 24 * RNN_STG_ROW;
constexpr int RNN_LDS_CW = 0;
constexpr int RNN_LDS_RC = 2560;
constexpr int RNN_LDS_TOT = 4096;
constexpr int RNN_LDS_STG = 8192;
constexpr int RNN_LDS_WF = 61440;

__device__ __forceinline__ float gelu_tanh(float x) {
    const float z2 = 1.5957691216057308f * (x + 0.044715f * x * x * x);
    return x * __builtin_amdgcn_rcpf(1.0f + __builtin_amdgcn_exp2f(-1.4426950408889634f * z2));
}
template <int D> __device__ __forceinline__ float dpp_shr(float old, float v) {
    return __builtin_bit_cast(float, __builtin_amdgcn_update_dpp(__builtin_bit_cast(int, old), __builtin_bit_cast(int, v), 0x110 + D, 0xf, 0xf, false));
}

struct RnnRows { v4u v[6]; v4u yg; };

template <bool SAMPLE>
__device__ __forceinline__ void rnn_rows_load(const Frame& F, const Args& A, int n, int q, int seq0, int tok0, RnnRows& R) {
    const int lane = F.lane, tk = lane & 15, kq = lane >> 4;
    const bf16* XR = (const bf16*)(A.ws + WS_XR); const bf16* YG = (const bf16*)(A.ws + WS_YG);
    constexpr int NROW = SAMPLE ? 22 : 19, NIT = (NROW * 16 + 63) / 64;
#pragma unroll
    for (int it = 0; it < NIT; ++it) {
        const int idx = lane + 64 * it; v4u val = {0u, 0u, 0u, 0u};
        if (idx < NROW * 16) {
            const int row = idx >> 4, c16 = idx & 15;
            if (SAMPLE) {
                const int s = row >= 11 ? 1 : 0, j = row - 11 * s, b = seq0 + s;
                if (j < 3) { const float* sp = A.in[4] + ((size_t)b * 3 + j) * DM + n * 128 + c16 * 8; const f32x4 a0 = *(const f32x4*)sp, a1 = *(const f32x4*)(sp + 4);
                    val.x = pk2(a0[0], a0[1]); val.y = pk2(a0[2], a0[3]); val.z = pk2(a1[0], a1[1]); val.w = pk2(a1[2], a1[3]); }
                else val = *(const v4u*)(XR + (size_t)(MP + b * 8 + (j - 3)) * DM + n * 128 + c16 * 8);
            } else {
                const int t = tok0 - 3 + row;
                if (t >= 0) val = *(const v4u*)(XR + (size_t)(seq0 * 2048 + t) * DM + n * 128 + c16 * 8);
            }
        }
        R.v[it] = val;
        if (SAMPLE && (it & 1)) asm volatile("" ::: "memory");
    }
    const int grow = SAMPLE ? (MP + (seq0 + (tk >> 3)) * 8 + (tk & 7)) : (seq0 * 2048 + tok0 + tk);
    R.yg = *(const v4u*)(YG + (size_t)grow * DM + n * 128 + q * 32 + kq * 8);
}

template <bool SAMPLE>
__device__ __forceinline__ void rnn_block(const Frame& F, const Args& A, int n, int q, int seq0, int tok0, RnnRows& R, float (&hc)[8], int parity, bool last_chunk) {
    const int lane = F.lane, tk = lane & 15, kq = lane >> 4, w = F.wave;
    bf16* OG = (bf16*)(A.ws + WS_C);
    LAS unsigned char* stg = F.lds + RNN_LDS_STG + w * RNN_STG_WAVE;
    const LAS float* cw = (const LAS float*)(F.lds + RNN_LDS_CW);
    constexpr int NROW = SAMPLE ? 22 : 19, NIT = (NROW * 16 + 63) / 64;
#pragma unroll
    for (int it = 0; it < NIT; ++it) { const int idx = lane + 64 * it; if (idx < NROW * 16) *(LAS v4u*)(stg + (idx >> 4) * RNN_STG_ROW + (idx & 15) * 16) = R.v[it]; }
    const v4u ygv = R.yg;
    const int grow = SAMPLE ? (MP + (seq0 + (tk >> 3)) * 8 + (tk & 7)) : (seq0 * 2048 + tok0 + tk);
    const int lrow = SAMPLE ? ((tk >> 3) * 11 + 3 + (tk & 7)) : (3 + tk);
    const int chg = n * 128 + q * 32 + kq * 8;
    LDS_WAIT(); asm volatile("" ::: "memory");
    pg8::bf16x8 bfrag[4]; float xcf[8];
#pragma unroll
    for (int ks = 0; ks < 4; ++ks) {
        const int kc = ks * 32 + kq * 8;
        float xc[8];
        { const f32x4 b0 = *(const LAS f32x4*)(cw + 4 * 128 + kc), b1 = *(const LAS f32x4*)(cw + 4 * 128 + kc + 4);
#pragma unroll
          for (int e = 0; e < 4; ++e) { xc[e] = b0[e]; xc[4 + e] = b1[e]; } }
#pragma unroll
        for (int d = 0; d < 4; ++d) {
            const v4u xv = *(const LAS v4u*)(stg + (lrow - d) * RNN_STG_ROW + kc * 2);
            const f32x4 w0 = *(const LAS f32x4*)(cw + (3 - d) * 128 + kc), w1 = *(const LAS f32x4*)(cw + (3 - d) * 128 + kc + 4);
            xc[0] += w0[0] * bflo(xv.x); xc[1] += w0[1] * bfhi(xv.x); xc[2] += w0[2] * bflo(xv.y); xc[3] += w0[3] * bfhi(xv.y);
            xc[4] += w1[0] * bflo(xv.z); xc[5] += w1[1] * bfhi(xv.z); xc[6] += w1[2] * bflo(xv.w); xc[7] += w1[3] * bfhi(xv.w);
        }
        v4u pk; pk.x = pk2(xc[0], xc[1]); pk.y = pk2(xc[2], xc[3]); pk.z = pk2(xc[4], xc[5]); pk.w = pk2(xc[6], xc[7]);
        bfrag[ks] = __builtin_bit_cast(pg8::bf16x8, pk);
        if (ks == q) {
#pragma unroll
            for (int e = 0; e < 8; ++e) xcf[e] = xc[e];
        }
        asm volatile("" ::: "memory");
    }
    f32x4 acc[4];
    const LAS v4u* wfl = (const LAS v4u*)(F.lds + RNN_LDS_WF) + lane;
#pragma unroll
    for (int mt = 0; mt < 4; ++mt) { acc[mt] = (f32x4){0.f, 0.f, 0.f, 0.f};
#pragma unroll
        for (int ks = 0; ks < 4; ++ks) acc[mt] = __builtin_amdgcn_mfma_f32_16x16x32_bf16(__builtin_bit_cast(pg8::bf16x8, wfl[(mt * 4 + ks) * 64]), bfrag[ks], acc[mt], 0, 0, 0); }
    asm volatile("" ::: "memory"); __builtin_amdgcn_sched_barrier(0);
    if (!SAMPLE && !last_chunk) rnn_rows_load<false>(F, A, n, q, seq0, tok0 + 128, R);
    float av[8], uv[8];
    const LAS float* rcp = (const LAS float*)(F.lds + RNN_LDS_RC) + kq * 8;
    float gbr[8], gbi[8], c8[8];
    { const f32x4 a0 = *(const LAS f32x4*)rcp, a1 = *(const LAS f32x4*)(rcp + 4), b0 = *(const LAS f32x4*)(rcp + 32), b1 = *(const LAS f32x4*)(rcp + 36), c0 = *(const LAS f32x4*)(rcp + 64), c1 = *(const LAS f32x4*)(rcp + 68);
#pragma unroll
      for (int e = 0; e < 4; ++e) { gbr[e] = a0[e]; gbr[4 + e] = a1[e]; gbi[e] = b0[e]; gbi[4 + e] = b1[e]; c8[e] = c0[e]; c8[4 + e] = c1[e]; } }
#pragma unroll
    for (int cj = 0; cj < 8; ++cj) {
        const float gr = acc[cj >> 2][cj & 3] + gbr[cj], gi = acc[2 + (cj >> 2)][cj & 3] + gbi[cj];
        const float r = fast_sig(gr), ig = fast_sig(gi);
        const float la = r * c8[cj];
        const float a = __builtin_amdgcn_exp2f(1.4426950408889634f * la);
        const float z = 2.0f * la;
        const float m = (z > -0.25f) ? (-z * (1.0f + z * (0.5f + z * (0.16666667f + z * (0.041666668f + z * (0.0083333338f + z * 0.0013888889f)))))) : (1.0f - a * a);
        av[cj] = a; uv[cj] = __builtin_amdgcn_sqrtf(m) * (ig * xcf[cj]);
    }
#define RNN_SCAN_STEP(D) do { const bool ok = !SAMPLE || (tk & 7) >= (D); _Pragma("unroll") for (int cj = 0; cj < 8; ++cj) { \
        const float ap = dpp_shr<D>(1.0f, av[cj]), up = dpp_shr<D>(0.0f, uv[cj]); if (ok) { uv[cj] = av[cj] * up + uv[cj]; av[cj] = av[cj] * ap; } } } while (0)
    RNN_SCAN_STEP(1); RNN_SCAN_STEP(2); RNN_SCAN_STEP(4);
    if (!SAMPLE) RNN_SCAN_STEP(8);
#undef RNN_SCAN_STEP
    float hin[8];
    if (SAMPLE) {
        const float* hp = A.in[5] + (size_t)(seq0 + (tk >> 3)) * DM + chg; const f32x4 h0 = *(const f32x4*)hp, h1 = *(const f32x4*)(hp + 4);
#pragma unroll
        for (int e = 0; e < 4; ++e) { hin[e] = h0[e]; hin[4 + e] = h1[e]; }
    } else {
        LAS float* tot = (LAS float*)(F.lds + RNN_LDS_TOT) + parity * 512;
        if (tk == 15) {
#pragma unroll
            for (int cj = 0; cj < 8; ++cj) { tot[w * 64 + kq * 8 + cj] = av[cj]; tot[w * 64 + 32 + kq * 8 + cj] = uv[cj]; }
        }
        __syncthreads();
#pragma unroll
        for (int cj = 0; cj < 8; ++cj) hin[cj] = hc[cj];
#pragma unroll
        for (int ww = 0; ww < 8; ++ww) {
            const f32x4 a0 = *(const LAS f32x4*)(tot + ww * 64 + kq * 8), a1 = *(const LAS f32x4*)(tot + ww * 64 + kq * 8 + 4);
            const f32x4 u0 = *(const LAS f32x4*)(tot + ww * 64 + 32 + kq * 8), u1 = *(const LAS f32x4*)(tot + ww * 64 + 32 + kq * 8 + 4);
#pragma unroll
            for (int e = 0; e < 4; ++e) {
                if (ww == w) { hin[e] = hc[e]; hin[4 + e] = hc[4 + e]; }
                hc[e] = a0[e] * hc[e] + u0[e]; hc[4 + e] = a1[e] * hc[4 + e] + u1[e];
            }
            if (ww & 1) asm volatile("" ::: "memory");
        }
    }
    float hv[8], ov[8];
    const float yg[8] = {bflo(ygv.x), bfhi(ygv.x), bflo(ygv.y), bfhi(ygv.y), bflo(ygv.z), bfhi(ygv.z), bflo(ygv.w), bfhi(ygv.w)};
#pragma unroll
    for (int cj = 0; cj < 8; ++cj) { hv[cj] = av[cj] * hin[cj] + uv[cj]; ov[cj] = hv[cj] * gelu_tanh(yg[cj]); }
    v4u o; o.x = pk2(ov[0], ov[1]); o.y = pk2(ov[2], ov[3]); o.z = pk2(ov[4], ov[5]); o.w = pk2(ov[6], ov[7]);
    *(v4u*)(OG + (size_t)grow * DM + chg) = o;
    if (SAMPLE) {
        if ((tk & 7) == 7) { float* hp = A.out + O_SH + (size_t)(seq0 + (tk >> 3)) * DM + chg;
            *(f32x4*)hp = (f32x4){hv[0], hv[1], hv[2], hv[3]}; *(f32x4*)(hp + 4) = (f32x4){hv[4], hv[5], hv[6], hv[7]}; }
    } else if (last_chunk && w == 7 && tk == 15) { float* hp = A.out + O_PH + (size_t)seq0 * DM + chg;
        *(f32x4*)hp = (f32x4){hv[0], hv[1], hv[2], hv[3]}; *(f32x4*)(hp + 4) = (f32x4){hv[4], hv[5], hv[6], hv[7]}; }
}

__device__ __forceinline__ void rnn_load_group(const Frame& F, const Args& A, int n, int q) {
    const v4u* wf = (const v4u*)(A.ws + WS_WGF) + (size_t)(n * 4 + q) * 1024; LAS v4u* wl = (LAS v4u*)(F.lds + RNN_LDS_WF);
    for (int i = F.tid; i < 1024; i += NWAVES * 64) wl[i] = wf[i];
    if (F.tid < 32) { LAS float* rcw = (LAS float*)(F.lds + RNN_LDS_RC); const int c = q * 32 + F.tid;
        rcw[F.tid] = A.in[15][n * 256 + c]; rcw[32 + F.tid] = A.in[15][n * 256 + 128 + c];
        const float lam = A.in[16][n * 128 + c];
        rcw[64 + F.tid] = 8.0f * (fminf(lam, 0.f) - log1pf(__expf(-fabsf(lam)))); }
}
__device__ __forceinline__ void rnn_load_convw(const Frame& F, const Args& A, int n) {
    LAS float* cw = (LAS float*)(F.lds + RNN_LDS_CW);
    for (int i = F.tid; i < 5 * 128; i += NWAVES * 64) { const int k = i >> 7, c = i & 127; cw[i] = (k < 4) ? A.in[12][k * DM + n * 128 + c] : A.in[13][n * 128 + c]; }
}

#ifndef RNN_REP
#define RNN_REP 1
#endif
__device__ __forceinline__ void rnn_phase(Frame& F, const Args& A) {
    const int gt = F.bx * (NWAVES * 64) + F.tid, NGT = F.G * NWAVES * 64;
    const bf16* XR = (const bf16*)(A.ws + WS_XR);
    for (int i = gt; i < (8 + 128) * 3 * 256; i += NGT) { const int c4 = (i & 255) * 4, rj = i >> 8, b = rj / 3, j = rj - 3 * b;
        const size_t srow = b < 8 ? ((size_t)b * 2048 + 2045 + j) : ((size_t)MP + (b - 8) * 8 + 5 + j);
        const uint2 v = *(const uint2*)(XR + srow * DM + c4);
        float* dst = b < 8 ? (A.out + O_PCONV + ((size_t)b * 3 + j) * DM + c4) : (A.out + O_SCONV + ((size_t)(b - 8) * 3 + j) * DM + c4);
        *(f32x4*)dst = (f32x4){bflo(v.x), bfhi(v.x), bflo(v.y), bfhi(v.y)}; }
    for (int u = F.bx; u < 256; u += F.G) {
        const int b = u >> 5, grp = u & 31, n = grp >> 2, q = grp & 3;
        __syncthreads();
        rnn_load_convw(F, A, n); rnn_load_group(F, A, n, q);
        __syncthreads();
#pragma unroll 1
        for (int rep = 0; rep < RNN_REP; ++rep) {
            float hc[8];
#pragma unroll
            for (int e = 0; e < 8; ++e) hc[e] = 0.f;
            RnnRows R; rnn_rows_load<false>(F, A, n, q, b, F.wave * 16, R);
#pragma unroll 1
            for (int ch = 0; ch < 16; ++ch) rnn_block<false>(F, A, n, q, b, ch * 128 + F.wave * 16, R, hc, ch & 1, ch == 15);
        }
#ifndef RNN_NO_SAMPLE
        {
            const int sb = (u >> 5) * 8 + F.wave; float hc[8];
            RnnRows R; rnn_rows_load<true>(F, A, n, q, 2 * sb, 0, R);
            rnn_block<true>(F, A, n, q, 2 * sb, 0, R, hc, 0, false);
        }
#endif
    }
    __syncthreads();
}

constexpr int AT_KROW = 144;
constexpr int AT_VROW = 400;
constexpr int AT_LDS_K = 0, AT_LDS_V = 192 * AT_KROW;
typedef float f32x16 __attribute__((ext_vector_type(16)));
typedef short s16x4 __attribute__((ext_vector_type(4)));

__device__ __forceinline__ int crow16(int r, int hi) { return (r & 3) + 8 * (r >> 2) + 4 * hi; }

template <bool SAMPLE>
__device__ __forceinline__ void attn_unit(const Frame& F, const Args& A, int b, int kvh, int tb) {
    constexpr int NKT = SAMPLE ? 5 : 6, NKEY = NKT * 32;
    const bf16* QB = (const bf16*)(A.ws + WS_Q); const bf16* KB = (const bf16*)(A.ws + WS_K); const bf16* VB = (const bf16*)(A.ws + WS_V); bf16* AO = (bf16*)(A.ws + WS_C);
    LAS unsigned char* Ks = F.lds + AT_LDS_K; LAS unsigned char* Vs = F.lds + AT_LDS_V;
    const int t0 = tb * 64, kbase = t0 - 128;
    for (int idx = F.tid; idx < NKEY * 8; idx += NWAVES * 64) {
        const int key = idx >> 3, c8 = idx & 7; v4u kv = {0u, 0u, 0u, 0u}, vv = {0u, 0u, 0u, 0u};
        if (SAMPLE) {
            if (key < 128) { const size_t off = (((size_t)b * 128 + key) * 4 + kvh) * 64 + c8 * 8; const float* kp = A.in[6] + off; const float* vp = A.in[7] + off;
                const f32x4 k0 = *(const f32x4*)kp, k1 = *(const f32x4*)(kp + 4), v0 = *(const f32x4*)vp, v1 = *(const f32x4*)(vp + 4);
                kv.x = pk2(k0[0], k0[1]); kv.y = pk2(k0[2], k0[3]); kv.z = pk2(k1[0], k1[1]); kv.w = pk2(k1[2], k1[3]);
                vv.x = pk2(v0[0], v0[1]); vv.y = pk2(v0[2], v0[3]); vv.z = pk2(v1[0], v1[1]); vv.w = pk2(v1[2], v1[3]); }
            else if (key < 136) { const size_t off = (size_t)(MP + b * 8 + (key - 128)) * 256 + kvh * 64 + c8 * 8; kv = *(const v4u*)(KB + off); vv = *(const v4u*)(VB + off); }
        } else {
            const int pos = kbase + key;
            if (pos >= 0) { const size_t off = (size_t)(b * 2048 + pos) * 256 + kvh * 64 + c8 * 8; kv = *(const v4u*)(KB + off); vv = *(const v4u*)(VB + off); }
        }
        *(LAS v4u*)(Ks + key * AT_KROW + c8 * 16) = kv;
        LAS unsigned short* vt = (LAS unsigned short*)(Vs + (c8 * 8) * AT_VROW + key * 2);
        vt[0 * (AT_VROW / 2)] = (unsigned short)(vv.x & 0xffffu); vt[1 * (AT_VROW / 2)] = (unsigned short)(vv.x >> 16);
        vt[2 * (AT_VROW / 2)] = (unsigned short)(vv.y & 0xffffu); vt[3 * (AT_VROW / 2)] = (unsigned short)(vv.y >> 16);
        vt[4 * (AT_VROW / 2)] = (unsigned short)(vv.z & 0xffffu); vt[5 * (AT_VROW / 2)] = (unsigned short)(vv.z >> 16);
        vt[6 * (AT_VROW / 2)] = (unsigned short)(vv.w & 0xffffu); vt[7 * (AT_VROW / 2)] = (unsigned short)(vv.w >> 16);
    }
    __syncthreads();
    if (!SAMPLE || F.wave == 0) {
        const int lane = F.lane, ql = lane & 31, hi = lane >> 5, w = F.wave;
        int grow, head, lo, hik;
        if (SAMPLE) { const int t = ql & 7, g = ql >> 3; grow = MP + b * 8 + t; head = kvh * 4 + g; lo = t; hik = 128 + t; }
        else { const int tl = 32 * (w >> 2) + ql; grow = b * 2048 + t0 + tl; head = kvh * 4 + (w & 3); hik = 128 + tl; lo = tl; if (lo < -kbase) lo = -kbase; }
        pg8::bf16x8 qf[4];
#pragma unroll
        for (int ks = 0; ks < 4; ++ks) qf[ks] = *(const pg8::bf16x8*)(QB + (size_t)grow * DM + head * 64 + ks * 16 + hi * 8);
        const float sink = A.in[23][head] * 1.4426950408889634f;
        f32x16 p[NKT];
#pragma unroll
        for (int kt = 0; kt < NKT; ++kt) {
            p[kt] = (f32x16){0.f, 0.f, 0.f, 0.f, 0.f, 0.f, 0.f, 0.f, 0.f, 0.f, 0.f, 0.f, 0.f, 0.f, 0.f, 0.f};
#pragma unroll
            for (int ks = 0; ks < 4; ++ks) { const pg8::bf16x8 kf = *(const LAS pg8::bf16x8*)(Ks + (kt * 32 + ql) * AT_KROW + ks * 32 + hi * 16);
                p[kt] = __builtin_amdgcn_mfma_f32_32x32x16_bf16(kf, qf[ks], p[kt], 0, 0, 0); }
        }
        float mx = sink;
#pragma unroll
        for (int kt = 0; kt < NKT; ++kt)
#pragma unroll
            for (int r = 0; r < 16; ++r) { const int i = kt * 32 + crow16(r, hi); const bool ok = (i >= lo) && (i <= hik); const float s = ok ? p[kt][r] : -1e30f; p[kt][r] = s; mx = fmaxf(mx, s); }
        mx = fmaxf(mx, __shfl_xor(mx, 32));
        float l = 0.f;
#pragma unroll
        for (int kt = 0; kt < NKT; ++kt)
#pragma unroll
            for (int r = 0; r < 16; ++r) { const float e = __builtin_amdgcn_exp2f(p[kt][r] - mx); p[kt][r] = e; l += e; }
        l += __shfl_xor(l, 32);
        l += __builtin_amdgcn_exp2f(sink - mx);
        const float rl = 1.0f / l;
        f32x16 o[2];
#pragma unroll
        for (int dt = 0; dt < 2; ++dt) o[dt] = (f32x16){0.f, 0.f, 0.f, 0.f, 0.f, 0.f, 0.f, 0.f, 0.f, 0.f, 0.f, 0.f, 0.f, 0.f, 0.f, 0.f};
#pragma unroll
        for (int kt = 0; kt < NKT; ++kt)
#pragma unroll
            for (int s = 0; s < 2; ++s) {
                v4u pw; pw.x = pk2(p[kt][8 * s + 0], p[kt][8 * s + 1]); pw.y = pk2(p[kt][8 * s + 2], p[kt][8 * s + 3]); pw.z = pk2(p[kt][8 * s + 4], p[kt][8 * s + 5]); pw.w = pk2(p[kt][8 * s + 6], p[kt][8 * s + 7]);
                const pg8::bf16x8 pb = __builtin_bit_cast(pg8::bf16x8, pw);
#pragma unroll
                for (int dt = 0; dt < 2; ++dt) {
                    const LAS unsigned char* vp = Vs + (dt * 32 + ql) * AT_VROW + (kt * 32 + s * 16 + hi * 4) * 2;
                    const s16x4 va = *(const LAS s16x4*)vp, vb = *(const LAS s16x4*)(vp + 16);
                    const pg8::bf16x8 vf = {va[0], va[1], va[2], va[3], vb[0], vb[1], vb[2], vb[3]};
                    o[dt] = __builtin_amdgcn_mfma_f32_32x32x16_bf16(vf, pb, o[dt], 0, 0, 0);
                }
            }
        bf16* orow = AO + (size_t)grow * DM + head * 64;
#pragma unroll
        for (int dt = 0; dt < 2; ++dt)
#pragma unroll
            for (int g = 0; g < 4; ++g) { uint2 w2; w2.x = pk2(o[dt][4 * g + 0] * rl, o[dt][4 * g + 1] * rl); w2.y = pk2(o[dt][4 * g + 2] * rl, o[dt][4 * g + 3] * rl);
                *(uint2*)(orow + dt * 32 + g * 8 + hi * 4) = w2; }
    }
    __syncthreads();
}

__device__ __forceinline__ void attn_phase(Frame& F, const Args& A) {
#ifndef ATT_REP
#define ATT_REP 1
#endif
#pragma unroll 1
    for (int u = F.bx; u < 1024 * ATT_REP; u += F.G) { const int v = u & 1023; attn_unit<false>(F, A, v >> 7, (v >> 5) & 3, v & 31); }
#pragma unroll 1
    for (int u = F.bx; u < 512 * ATT_REP; u += F.G) { const int v = u & 511; attn_unit<true>(F, A, v >> 2, v & 3, 0); }
}

__global__ void __launch_bounds__(NWAVES * 64, 2) trunk_fwd(Args A) {
    extern __shared__ __attribute__((aligned(16))) unsigned char lds[];
    Frame F;
    F.lds = (LAS unsigned char*)lds;
    F.tid = threadIdx.x; F.lane = F.tid & 63; F.wave = __builtin_amdgcn_readfirstlane(F.tid >> 6);
    F.G = gridDim.x; F.bx = blockIdx.x;
    unsigned char* ws = A.ws;
    gu32* ctl = (gu32*)(ws + WS_CTL);
    for (int u = F.tid; u < (LDS_BYTES - LDSCTL_OFF) / 4; u += NWAVES * 64) ((LAS unsigned*)(F.lds + LDSCTL_OFF))[u] = 0u;
    __syncthreads();
    const int lo = A.ph_lo, hi = A.ph_hi;
    const bool multi = (hi - lo) > 1;
    XcdBarrier bar; bar.bar = (unsigned*)(ctl + CW_BAR); bar.x = 0; bar.st = nullptr;
    if (multi) bar = xcd_barrier_post((unsigned*)(ctl + CW_BAR), (volatile LAS unsigned*)(F.lds + MISC_OFF) + 8);
#ifndef PH_MASK
#define PH_MASK 0
#endif
#define IN(k) (lo <= (k) && (k) < hi && !((PH_MASK >> (k)) & 1))
#ifndef PH_REP
#define PH_REP 0
#endif
#define SEAM(k) do { if (IN(k) && IN((k) + 1)) xcd_barrier(bar); } while (0)
#define REP(k) for (int rep_ = 0; rep_ < 1 + ((PH_REP >> (k)) & 1); ++rep_)
    PG8_LAS unsigned char* ring = (PG8_LAS unsigned char*)(F.lds + RING_OFF);
    const float* MODS = (const float*)(ws + WS_MODS);
    bf16* H = (bf16*)(ws + WS_C); bf16* HK = (bf16*)(ws + WS_HK);
    constexpr int NOSPLIT = 1 << 30;

    if (IN(0)) REP(0) { p0_prologue(F, A); SEAM(0); }
    if (IN(1)) REP(1) {
        pg8::Gemm g{(const pg8::bf16_t*)(ws + WS_SC), (const pg8::bf16_t*)(ws + WS_SC), NOSPLIT, (const pg8::bf16_t*)(ws + WS_WADA), 256, NMOD, 1024};
        pg8::StaticOrder S; S.init(256, NMOD, F.G, F.bx, 1024);
        pg8::EpiAda E{(float*)(ws + WS_MODS), A.in[9], A.in[19]};
        pg8::gemm_phase<pg8::EpiAda, pg8::StaticOrder, true, true>(ring, g, S, E);
        SEAM(1);
    }
    if (IN(2)) REP(2) { norm_phase<0>(F, A, true, A.in[10], 0, 1024, H, nullptr, 0, 0, nullptr); SEAM(2); }
    if (IN(3)) REP(3) {
        pg8::Gemm g{(const pg8::bf16_t*)H, (const pg8::bf16_t*)H, NOSPLIT, (const pg8::bf16_t*)(ws + WS_WIN), MT, 2048, 1024};
        pg8::StaticOrder S; S.init(MT, 2048, F.G, F.bx, 1024);
        pg8::EpiBf16x2 E{(pg8::bf16_t*)(ws + WS_XR), (pg8::bf16_t*)(ws + WS_YG)};
        pg8::gemm_phase<pg8::EpiBf16x2, pg8::StaticOrder, true, true>(ring, g, S, E);
        SEAM(3);
    }
    if (IN(4)) REP(4) { rnn_phase(F, A); SEAM(4); }
    if (IN(5)) REP(5) {
        pg8::Gemm g{(const pg8::bf16_t*)H, (const pg8::bf16_t*)H, NOSPLIT, (const pg8::bf16_t*)(ws + WS_WOUT), MT, 1024, 1024};
        pg8::SplitOrder S; S.init(MP, MS, 1024, F.G, F.bx, 1024, 4);
        pg8::EpiResGate E{A.in[0], A.in[1], A.out, MODS, 2048, (float*)(ws + WS_SLAB), A.dry};
        pg8::gemm_phase<pg8::EpiResGate, pg8::SplitOrder, true, true>(ring, g, S, E);
        SEAM(5);
    }
    if (IN(6)) REP(6) { norm_phase<4>(F, A, false, A.in[10] + 1024, 3072, 4096, H, nullptr, 0, 0, nullptr); SEAM(6); }
    if (IN(7)) REP(7) {
        pg8::Gemm g{(const pg8::bf16_t*)H, (const pg8::bf16_t*)H, NOSPLIT, (const pg8::bf16_t*)(ws + WS_WFI), MT, 2 * FF, 1024};
        pg8::StaticOrder S; S.init(MT, 2 * FF, F.G, F.bx, 1024);
        pg8::EpiSwiGLU E{(pg8::bf16_t*)(ws + WS_ACT)};
        pg8::gemm_phase<pg8::EpiSwiGLU, pg8::StaticOrder, true, true>(ring, g, S, E);
        SEAM(7);
    }
    if (IN(8)) REP(8) {
        pg8::Gemm g{(const pg8::bf16_t*)(ws + WS_ACT), (const pg8::bf16_t*)(ws + WS_ACT), NOSPLIT, (const pg8::bf16_t*)(ws + WS_WFO), MT, 1024, FF};
        pg8::SplitOrder S; S.init(MP, MS, 1024, F.G, F.bx, FF, 5);
        pg8::EpiResGate E{A.out, A.out + (size_t)MP * DM, A.out, MODS, 5120, (float*)(ws + WS_SLAB), A.dry};
        pg8::gemm_phase<pg8::EpiResGate, pg8::SplitOrder, true, true>(ring, g, S, E);
        SEAM(8);
    }
    if (IN(9)) REP(9) { norm_phase<5>(F, A, false, A.in[10] + 2048, 6144, 6144 + 1024, H, A.in[20], 12288, 13312, HK); SEAM(9); }
    if (IN(10)) REP(10) {
        pg8::Gemm g{(const pg8::bf16_t*)HK, (const pg8::bf16_t*)H, 2, (const pg8::bf16_t*)(ws + WS_WKVQ), MT, 1536, 1024};
        pg8::StaticOrder S; S.init(MT, 1536, F.G, F.bx, 1024);
        pg8::EpiKVQ E{(pg8::bf16_t*)(ws + WS_K), (pg8::bf16_t*)(ws + WS_V), (pg8::bf16_t*)(ws + WS_Q), (const float*)(ws + WS_ROPE), A.out};
        pg8::gemm_phase<pg8::EpiKVQ, pg8::StaticOrder, true, true>(ring, g, S, E);
        SEAM(10);
    }
    if (IN(11)) REP(11) { attn_phase(F, A); SEAM(11); }
    if (IN(12)) REP(12) {
        pg8::Gemm g{(const pg8::bf16_t*)H, (const pg8::bf16_t*)H, NOSPLIT, (const pg8::bf16_t*)(ws + WS_WO), MT, 1024, 1024};
        pg8::SplitOrder S; S.init(MP, MS, 1024, F.G, F.bx, 1024, 4);
        pg8::EpiResGate E{A.out, A.out + (size_t)MP * DM, A.out, MODS, 6144 + 2048, (float*)(ws + WS_SLAB), A.dry};
        pg8::gemm_phase<pg8::EpiResGate, pg8::SplitOrder, true, true>(ring, g, S, E);
        SEAM(12);
    }
    if (IN(13)) REP(13) { norm_phase<4>(F, A, false, A.in[10] + 3072, 6144 + 3072, 6144 + 4096, H, nullptr, 0, 0, nullptr); SEAM(13); }
    if (IN(14)) REP(14) {
        pg8::Gemm g{(const pg8::bf16_t*)H, (const pg8::bf16_t*)H, NOSPLIT, (const pg8::bf16_t*)(ws + WS_WFI + WFI_BYTES), MT, 2 * FF, 1024};
        pg8::StaticOrder S; S.init(MT, 2 * FF, F.G, F.bx, 1024);
        pg8::EpiSwiGLU E{(pg8::bf16_t*)(ws + WS_ACT)};
        pg8::gemm_phase<pg8::EpiSwiGLU, pg8::StaticOrder, true, true>(ring, g, S, E);
        SEAM(14);
    }
    if (IN(15)) REP(15) {
        pg8::Gemm g{(const pg8::bf16_t*)(ws + WS_ACT), (const pg8::bf16_t*)(ws + WS_ACT), NOSPLIT, (const pg8::bf16_t*)(ws + WS_WFO + WFO_BYTES), MT, 1024, FF};
        pg8::SplitOrder S; S.init(MP, MS, 1024, F.G, F.bx, FF, 5);
        pg8::EpiResGate E{A.out, A.out + (size_t)MP * DM, A.out, MODS, 6144 + 5120, (float*)(ws + WS_SLAB), A.dry};
        pg8::gemm_phase<pg8::EpiResGate, pg8::SplitOrder, true, true>(ring, g, S, E);
        SEAM(15);
    }
    if (IN(16)) REP(16) { final_norm_phase<5>(F, A, A.in[27]); }
#undef IN
#undef SEAM
}

#ifndef N_LAUNCH_MODE
#define N_LAUNCH_MODE 1
#endif
extern "C" void kernel_launch(void* const* d_in, const int* in_sizes, int n_in, void* d_out, int out_size, void* d_ws, size_t ws_size, hipStream_t stream) {
    static int grid = 0;
    if (grid == 0) {
        if (n_in != 28 || out_size != (int)O_END || ws_size < WS_END) { fprintf(stderr, "kernel_launch: unexpected problem shape (n_in %d, out %d, ws %zu)\n", n_in, out_size, ws_size); grid = -1; return; }
        int dev = 0, cus = 0, per_cu = 0;
        if (hipGetDevice(&dev) != hipSuccess || hipDeviceGetAttribute(&cus, hipDeviceAttributeMultiprocessorCount, dev) != hipSuccess) { grid = -1; return; }
        if (hipFuncSetAttribute((const void*)trunk_fwd, hipFuncAttributeMaxDynamicSharedMemorySize, LDS_BYTES) != hipSuccess) { fprintf(stderr, "kernel_launch: hipFuncSetAttribute failed\n"); grid = -1; return; }
        if (hipOccupancyMaxActiveBlocksPerMultiprocessor(&per_cu, (const void*)trunk_fwd, NWAVES * 64, LDS_BYTES) != hipSuccess || per_cu < 1) { fprintf(stderr, "kernel_launch: occupancy query says %d blocks per CU\n", per_cu); per_cu = 1; }
        (void)hipGetLastError();
        grid = cus;
    }
    if (grid < 0) return;
    (void)hipMemsetAsync((char*)d_ws + WS_CTL, 0, CTL_ZERO_BYTES, stream);
    Args a{};
    for (int i = 0; i < 28; ++i) a.in[i] = (const float*)d_in[i];
    a.out = (float*)d_out; a.ws = (unsigned char*)d_ws;
    for (int f = 0; f < 8; ++f) a.inv[f] = (float)pow(500000.0, -(double)(2 * f) / 16.0);
#if N_LAUNCH_MODE == 1
    a.ph_lo = 0; a.ph_hi = NPHASE;
    hipLaunchKernelGGL(trunk_fwd, dim3(grid), dim3(NWAVES * 64), LDS_BYTES, stream, a);
#else
#ifndef PROBE_DUP
#define PROBE_DUP 0
#endif
#ifndef PROBE_DRY
#define PROBE_DRY 0
#endif
    for (int p = 0; p < NPHASE; ++p) { a.ph_lo = p; a.ph_hi = p + 1;
        for (int d = 0; d < 1 + ((PROBE_DUP >> p) & 1); ++d) { a.dry = (PROBE_DRY && d == 0 && ((PROBE_DUP >> p) & 1)) ? 1 : 0; hipLaunchKernelGGL(trunk_fwd, dim3(grid), dim3(NWAVES * 64), LDS_BYTES, stream, a); } }
#endif
}
```
